# Optimizing an MI355X kernel written in HIP

```python
import math
import jax, jax.numpy as jnp
from jax import lax
import numpy as np

D_MODEL = 1024
BATCH = 4
SEQ = 4096
DEPTH = 1
DEC_BATCH = 8
DEC_SEQ = 8192
PAST_LEN = 128

A_HEADS = 8
A_HEAD_DIM = 64
A_VALUE_DIM = 2 * A_HEAD_DIM
A_QK = A_HEADS * 2 * A_HEAD_DIM
A_WIDTH = A_HEADS * A_VALUE_DIM
Q_BLOCK = 128
NUM_BUCKETS = 32
MAX_DISTANCE = 128
G_HEADS = 8
G_KEY_DIM = 128
G_VALUE_DIM = 128
G_KWIDTH = G_HEADS * G_KEY_DIM
G_VWIDTH = G_HEADS * G_VALUE_DIM
CHUNK = 64
D_FF = 4 * D_MODEL
EPS = 1e-6

IN_SPLITS = (A_QK, A_QK, A_WIDTH, G_KWIDTH, G_KWIDTH, G_KWIDTH, G_VWIDTH, G_VWIDTH, D_MODEL, D_MODEL)
IN_WIDTH = sum(IN_SPLITS)
SPLIT_IDX = tuple(int(s) for s in np.cumsum(IN_SPLITS)[:-1])

kernel_name = 'hybrid_diffattn_hgrn2_gated_encoder'


def rmsnorm(x, g):
    xf = x.astype(jnp.float32)
    y = xf * lax.rsqrt(jnp.mean(xf * xf, axis=-1, keepdims=True) + EPS)
    return (y * g.astype(jnp.float32)).astype(x.dtype)


def t5_bucket(rel):
    nb = NUM_BUCKETS // 2
    ret = (rel > 0).astype(jnp.int32) * nb
    n = jnp.abs(rel)
    max_exact = nb // 2
    is_small = n < max_exact
    nf = jnp.maximum(n, 1).astype(jnp.float32)
    large = max_exact + (jnp.log(nf / max_exact) / math.log(MAX_DISTANCE / max_exact)
                         * (nb - max_exact)).astype(jnp.int32)
    large = jnp.minimum(large, nb - 1)
    return ret + jnp.where(is_small, n, large)


def diff_attention(q, k, v, rel_bias, lam, lam_init, g_sub):
    B, T = q.shape[0], q.shape[1]
    nblk = T // Q_BLOCK
    scale = A_HEAD_DIM ** -0.5
    kpos = jnp.arange(T, dtype=jnp.int32)
    qb = q.reshape(B, nblk, Q_BLOCK, A_HEADS, 2, A_HEAD_DIM).transpose(1, 0, 2, 3, 4, 5)
    starts = jnp.arange(nblk, dtype=jnp.int32) * Q_BLOCK

    def block(args):
        qblk, start = args
        s = jnp.einsum('bqhcd,bkhcd->bhcqk', qblk, k).astype(jnp.float32) * scale
        qpos = start + jnp.arange(Q_BLOCK, dtype=jnp.int32)
        bucket = t5_bucket(kpos[None, :] - qpos[:, None])
        bias = jnp.transpose(rel_bias[bucket].astype(jnp.float32), (2, 0, 1))
        p = jax.nn.softmax(s + bias[None, :, None], axis=-1)
        w = p[:, :, 0] - lam * p[:, :, 1]
        return jnp.einsum('bhqk,bkhv->bqhv', w.astype(v.dtype), v)

    o = lax.map(block, (qb, starts))
    o = o.transpose(1, 0, 2, 3, 4).reshape(B, T, A_HEADS, A_VALUE_DIM)
    o = rmsnorm(o, g_sub) * (1.0 - lam_init)
    return o.reshape(B, T, A_WIDTH)


def gla_chunk_scan(q, k, v, g):
    B, H, T, dk = q.shape
    dv = v.shape[-1]
    n = T // CHUNK

    def chunks(a):
        return jnp.moveaxis(a.reshape(B, H, n, CHUNK, a.shape[-1]), 2, 0)

    mask = jnp.tril(jnp.ones((CHUNK, CHUNK), dtype=bool))[..., None]

    def step(S, inp):
        qc, kc, vc, gc = inp
        b = jnp.cumsum(gc, axis=-2)
        diff = b[..., :, None, :] - b[..., None, :, :]
        decay = jnp.where(mask, jnp.exp(jnp.where(mask, diff, 0.0)), 0.0)
        A = jnp.einsum('bhtk,bhsk,bhtsk->bhts', qc, kc, decay)
        o = (jnp.einsum('bhtk,bhkv->bhtv', qc * jnp.exp(b), S)
             + jnp.einsum('bhts,bhsv->bhtv', A, vc))
        bl = b[..., -1:, :]
        S = (jnp.exp(bl)[..., 0, :, None] * S
             + jnp.einsum('bhsk,bhsv->bhkv', kc * jnp.exp(bl - b), vc))
        return S, o

    S0 = jnp.zeros((B, H, dk, dv), jnp.float32)
    _, o = lax.scan(step, S0, (chunks(q), chunks(k), chunks(v), chunks(g)))
    return jnp.moveaxis(o, 0, 2).reshape(B, H, T, dv)


def hgrn2_bidir(q, zf_fwd, zf_bwd, i, og, lb_f, lb_b, g_out):
    B, T = q.shape[0], q.shape[1]

    def heads(a, d):
        return a.astype(jnp.float32).reshape(B, T, G_HEADS, d).transpose(0, 2, 1, 3)

    qh = heads(q, G_KEY_DIM)
    vh = heads(i, G_VALUE_DIM)

    def direction(zf, lb, flip):
        f = lb + (1.0 - lb) * jax.nn.sigmoid(zf.astype(jnp.float32))
        kh = heads(1.0 - f, G_KEY_DIM)
        gh = heads(jnp.log(f), G_KEY_DIM)
        if flip:
            o = gla_chunk_scan(jnp.flip(qh, 2), jnp.flip(kh, 2), jnp.flip(vh, 2), jnp.flip(gh, 2))
            return jnp.flip(o, 2)
        return gla_chunk_scan(qh, kh, vh, gh)

    o = direction(zf_fwd, lb_f, False) + direction(zf_bwd, lb_b, True)
    o = o.transpose(0, 2, 1, 3)
    gate = jax.nn.silu(og.astype(jnp.float32)).reshape(B, T, G_HEADS, G_VALUE_DIM)
    o = rmsnorm(o, g_out) * gate
    return o.reshape(B, T, G_VWIDTH).astype(q.dtype)


def encoder_layer(x, l, rel_bias, g_mix_pre, w_in, lam_q1, lam_k1, lam_q2, lam_k2, g_attn_sub,
                  lb_fwd, lb_bwd, g_hgrn_out, w_proj_a, w_proj_b, w_out, g_mix_post,
                  g_mlp_pre, w_mlp_up, w_mlp_down, g_mlp_post):
    B, T = x.shape[0], x.shape[1]
    h = rmsnorm(x, g_mix_pre[l])
    proj = h @ w_in[l]
    aq, ak, av, gq, gff, gfb, gi, gog, ga, gb = jnp.split(proj, SPLIT_IDX, axis=-1)

    lam_init = 0.8 - 0.6 * math.exp(-0.3 * l)
    lam = (jnp.exp(jnp.sum(lam_q1[l].astype(jnp.float32) * lam_k1[l].astype(jnp.float32)))
           - jnp.exp(jnp.sum(lam_q2[l].astype(jnp.float32) * lam_k2[l].astype(jnp.float32)))
           + lam_init)
    o_a = diff_attention(aq.reshape(B, T, A_HEADS, 2, A_HEAD_DIM),
                         ak.reshape(B, T, A_HEADS, 2, A_HEAD_DIM),
                         av.reshape(B, T, A_HEADS, A_VALUE_DIM),
                         rel_bias, lam, lam_init, g_attn_sub[l])

    lb_f = jnp.cumsum(jax.nn.softmax(lb_fwd.astype(jnp.float32), axis=0), axis=0)[l]
    lb_b = jnp.cumsum(jax.nn.softmax(lb_bwd.astype(jnp.float32), axis=0), axis=0)[l]
    o_b = hgrn2_bidir(gq, gff, gfb, gi, gog, lb_f, lb_b, g_hgrn_out[l])

    merged = jax.nn.sigmoid(ga) * (o_a @ w_proj_a[l]) + jax.nn.sigmoid(gb) * (o_b @ w_proj_b[l])
    x = x + rmsnorm(merged @ w_out[l], g_mix_post[l])

    h = rmsnorm(x, g_mlp_pre[l])
    u = jnp.square(jax.nn.relu(h @ w_mlp_up[l]))
    return x + rmsnorm(u @ w_mlp_down[l], g_mlp_post[l])


def setup_inputs(seed: int = 0) -> dict:
    key = jax.random.key(seed)
    ks = jax.random.split(key, 24)
    nrm = jax.random.normal

    def gain(k, d):
        return 1.0 + 0.05 * nrm(k, (DEPTH, d), jnp.float32)

    return {
        'x_prompt': nrm(ks[0], (BATCH, SEQ, D_MODEL), jnp.float32),
        'x_sample': nrm(ks[1], (DEC_BATCH, DEC_SEQ, D_MODEL), jnp.float32),
        'rel_bias': 0.5 * nrm(ks[2], (NUM_BUCKETS, A_HEADS), jnp.float32),
        'g_mix_pre': gain(ks[3], D_MODEL),
        'w_in': nrm(ks[4], (DEPTH, D_MODEL, IN_WIDTH), jnp.float32) * D_MODEL ** -0.5,
        'lam_q1': 0.1 * nrm(ks[5], (DEPTH, A_HEAD_DIM), jnp.float32),
        'lam_k1': 0.1 * nrm(ks[6], (DEPTH, A_HEAD_DIM), jnp.float32),
        'lam_q2': 0.1 * nrm(ks[7], (DEPTH, A_HEAD_DIM), jnp.float32),
        'lam_k2': 0.1 * nrm(ks[8], (DEPTH, A_HEAD_DIM), jnp.float32),
        'g_attn_sub': gain(ks[9], A_VALUE_DIM),
        'lb_fwd': 0.5 * nrm(ks[10], (DEPTH + 1, G_KWIDTH), jnp.float32),
        'lb_bwd': 0.5 * nrm(ks[11], (DEPTH + 1, G_KWIDTH), jnp.float32),
        'g_hgrn_out': gain(ks[12], G_VALUE_DIM),
        'w_proj_a': nrm(ks[13], (DEPTH, A_WIDTH, D_MODEL), jnp.float32) * A_WIDTH ** -0.5,
        'w_proj_b': nrm(ks[14], (DEPTH, G_VWIDTH, D_MODEL), jnp.float32) * G_VWIDTH ** -0.5,
        'w_out': nrm(ks[15], (DEPTH, D_MODEL, D_MODEL), jnp.float32) * D_MODEL ** -0.5,
        'g_mix_post': gain(ks[16], D_MODEL),
        'g_mlp_pre': gain(ks[17], D_MODEL),
        'w_mlp_up': nrm(ks[18], (DEPTH, D_MODEL, D_FF), jnp.float32) * D_MODEL ** -0.5,
        'w_mlp_down': nrm(ks[19], (DEPTH, D_FF, D_MODEL), jnp.float32) * D_FF ** -0.5,
        'g_mlp_post': gain(ks[20], D_MODEL),
    }


def reference(x_prompt, x_sample, rel_bias, g_mix_pre, w_in, lam_q1, lam_k1, lam_q2, lam_k2,
              g_attn_sub, lb_fwd, lb_bwd, g_hgrn_out, w_proj_a, w_proj_b, w_out, g_mix_post,
              g_mlp_pre, w_mlp_up, w_mlp_down, g_mlp_post):
    def trunk(x):
        for l in range(DEPTH):
            x = encoder_layer(x, l, rel_bias, g_mix_pre, w_in, lam_q1, lam_k1, lam_q2, lam_k2,
                              g_attn_sub, lb_fwd, lb_bwd, g_hgrn_out, w_proj_a, w_proj_b, w_out,
                              g_mix_post, g_mlp_pre, w_mlp_up, w_mlp_down, g_mlp_post)
        return x

    y_prompt = trunk(x_prompt)
    y_sample = trunk(x_sample)
    return (y_prompt, y_sample)
```

```cpp
#include <hip/hip_runtime.h>
#include <hip/hip_cooperative_groups.h>
#include <cstdio>
#include <cstdint>
namespace cg = cooperative_groups;

#ifndef N_LAUNCH_MODE
#define N_LAUNCH_MODE 1
#endif

#define LAS __attribute__((address_space(3)))
typedef unsigned short bf16_t;
typedef short bf16x8 __attribute__((ext_vector_type(8)));
typedef float f32x4 __attribute__((ext_vector_type(4)));
typedef float f32x16 __attribute__((ext_vector_type(16)));
typedef unsigned u32x4 __attribute__((ext_vector_type(4)));
typedef unsigned u32x2 __attribute__((ext_vector_type(2)));
typedef float f32x2_t __attribute__((ext_vector_type(2)));
typedef __bf16 bf16x2_t __attribute__((ext_vector_type(2)));

constexpr int D = 1024, NPROJ = 10240, FF = 4096;
constexpr int MR = 16384;
constexpr int NROUND = 5;
constexpr float EPS = 1e-6f;
constexpr float LOG2E = 1.4426950408889634f;
constexpr float QSCALE = 0.125f * LOG2E;
constexpr int C_AQ = 0, C_AK = 1024, C_AV = 2048, C_GQ = 3072, C_GFF = 4096, C_GFB = 5120, C_GI = 6144, C_GOG = 7168, C_GA = 8192, C_GB = 9216;

constexpr size_t MiB = 1u << 20;
constexpr size_t WS_CTL = 0;
constexpr size_t WS_WIN = 1 * MiB, WS_WA = 21 * MiB, WS_WB = 23 * MiB, WS_WOUT = 25 * MiB, WS_WUP = 27 * MiB, WS_WDN = 35 * MiB;
constexpr size_t WS_HB = 44 * MiB, WS_PROJ = 76 * MiB, WS_U = WS_PROJ, WS_VT = 396 * MiB, WS_OA = 428 * MiB, WS_OB = 460 * MiB;
constexpr size_t WS_MERGED = 492 * MiB, WS_Y = 524 * MiB, WS_OPART = 556 * MiB, WS_STASH = 684 * MiB, WS_END = 716 * MiB;

__device__ __forceinline__ float bf2f(unsigned u) { return __uint_as_float(u << 16); }
__device__ __forceinline__ unsigned cvtpk(float lo, float hi) { f32x2_t v = {lo, hi}; bf16x2_t b = __builtin_convertvector(v, bf16x2_t); return __builtin_bit_cast(unsigned, b); }
__device__ __forceinline__ bf16_t f2bf(float f) { return (bf16_t)(cvtpk(f, 0.f) & 0xffffu); }
__device__ __forceinline__ float fexp2(float x) { return __builtin_amdgcn_exp2f(x); }
__device__ __forceinline__ float flog2(float x) { return __builtin_amdgcn_logf(x); }
__device__ __forceinline__ float frcp(float x) { return __builtin_amdgcn_rcpf(x); }
__device__ __forceinline__ float sigmoidf_(float x) { return frcp(1.f + fexp2(-x * LOG2E)); }
__device__ __forceinline__ int crow(int r, int hi) { return (r & 3) + 8 * (r >> 2) + 4 * hi; }

namespace pg8 {
constexpr int BM = 256, BK = 64, HALF = 128, HTB = HALF * BK * 2, STAGE_BYTES = 8 * HTB, NXCD = 8, WGM = 8;
__host__ __device__ __forceinline__ int lds_byte(int r, int c) { const int st = (r >> 4) * 2 + (c >> 5), rr = r & 15, cc = c & 31, ob = rr * 64 + cc * 2; return st * 1024 + (ob ^ (((ob >> 9) & 1) << 5)); }
__host__ __device__ __forceinline__ void stage_rc(int b, int& R, int& C) { const int st = b / 1024, sb = b % 1024, swz = sb ^ (((sb >> 9) & 1) << 5); R = (st >> 1) * 16 + swz / 64; C = (st & 1) * 32 + (swz % 64) / 2; }
__host__ __device__ __forceinline__ int perm32(int rho) { const int n = rho >> 4, i = rho & 15; return 8 * (i >> 2) + 4 * n + (i & 3); }
struct Unit { int pm, pn; };
struct Gemm { const bf16_t* A; const bf16_t* Bt; int M, N, K; };
struct StaticOrder {
    int nM, nN, nwg, G, c;
    __host__ __device__ void init(int M, int N, int G_, int c_) { nM = M / BM; nN = N / BM; nwg = nM * nN; G = G_; c = c_; }
    __host__ __device__ bool next(int i, Unit& u) const {
        const long L = (long)i * G + c; if (L >= nwg) return false;
        int wgid = (int)L; { const int q = nwg / NXCD, r = nwg % NXCD, xcd = wgid % NXCD, off = wgid / NXCD; wgid = (xcd < r ? xcd * (q + 1) : r * (q + 1) + (xcd - r) * q) + off; }
        const int nig = WGM * nN, gid = wgid / nig, fm = gid * WGM, gsz = (nM - fm) < WGM ? (nM - fm) : WGM;
        u.pm = fm + ((wgid % nig) % gsz); u.pn = (wgid % nig) / gsz; return true;
    }
    __device__ __forceinline__ void a_ready(const Unit&) const {}
    __device__ __forceinline__ void done(const Unit&) const {}
};

template <int MODE> struct Epi {
    static constexpr bool PERM = true, AFTER_DRAIN = false;
    bf16_t* O; int ldc; const bf16_t* G; int ldg; int gcol0; bf16_t* VT; int T;
    __device__ __forceinline__ void operator()(const f32x4 (&acc)[2][2][4][2], const Unit& u, int wr, int wc, int fr, int fq) const {
        const int row0 = u.pm * BM + wr * 64 + fr; const int colt = u.pn * BM; const int col0 = colt + wc * 32 + 8 * fq;
        if (MODE == 1 && colt >= C_AV && colt < C_AV + 1024) {
            const int s = (u.pm * BM) / T, t0 = (u.pm * BM) % T;
            const int pf = (fr & 3) | ((fr & 4) << 1) | ((fr & 8) >> 1);
#pragma unroll
            for (int ai = 0; ai < 2; ++ai)
#pragma unroll
                for (int m = 0; m < 4; ++m) { const int tpos = t0 + ai * 128 + wr * 64 + m * 16 + pf;
#pragma unroll
                    for (int bj = 0; bj < 2; ++bj) { const int head = (colt - C_AV) / 128 + bj;
#pragma unroll
                        for (int n = 0; n < 2; ++n)
#pragma unroll
                            for (int j = 0; j < 4; ++j) { const int dv = wc * 32 + 8 * fq + 4 * n + j;
                                VT[((size_t)(s * 8 + head) * 128 + dv) * T + tpos] = f2bf(acc[ai][bj][m][n][j]); } } }
            return;
        }
#pragma unroll
        for (int ai = 0; ai < 2; ++ai)
#pragma unroll
            for (int m = 0; m < 4; ++m) { const size_t row = (size_t)(row0 + ai * HALF + m * 16); bf16_t* rowp = O + row * ldc + col0;
#pragma unroll
                for (int bj = 0; bj < 2; ++bj) { f32x4 v0 = acc[ai][bj][m][0], v1 = acc[ai][bj][m][1];
                    if (MODE == 2 || MODE == 3) {
                        const u32x4 gw = *(const u32x4*)(G + row * ldg + gcol0 + col0 + bj * HALF);
                        v0[0] *= sigmoidf_(bf2f(gw[0] & 0xffffu)); v0[1] *= sigmoidf_(bf2f(gw[0] >> 16)); v0[2] *= sigmoidf_(bf2f(gw[1] & 0xffffu)); v0[3] *= sigmoidf_(bf2f(gw[1] >> 16));
                        v1[0] *= sigmoidf_(bf2f(gw[2] & 0xffffu)); v1[1] *= sigmoidf_(bf2f(gw[2] >> 16)); v1[2] *= sigmoidf_(bf2f(gw[3] & 0xffffu)); v1[3] *= sigmoidf_(bf2f(gw[3] >> 16));
                    }
                    if (MODE == 3) {
                        const u32x4 ow = *(const u32x4*)(rowp + bj * HALF);
                        v0[0] += bf2f(ow[0] & 0xffffu); v0[1] += bf2f(ow[0] >> 16); v0[2] += bf2f(ow[1] & 0xffffu); v0[3] += bf2f(ow[1] >> 16);
                        v1[0] += bf2f(ow[2] & 0xffffu); v1[1] += bf2f(ow[2] >> 16); v1[2] += bf2f(ow[3] & 0xffffu); v1[3] += bf2f(ow[3] >> 16);
                    }
                    if (MODE == 4) {
#pragma unroll
                        for (int j = 0; j < 4; ++j) { float a = fmaxf(v0[j], 0.f), b = fmaxf(v1[j], 0.f); v0[j] = a * a; v1[j] = b * b; }
                    }
                    u32x4 w; w.x = cvtpk(v0[0], v0[1]); w.y = cvtpk(v0[2], v0[3]); w.z = cvtpk(v1[0], v1[1]); w.w = cvtpk(v1[2], v1[3]);
                    *(u32x4*)(rowp + bj * HALF) = w; } }
    }
};

template <class EpiT, class Sched, bool ALIGN_EPI = false, bool SP2 = false>
__device__ __forceinline__ void gemm_phase(LAS unsigned char* lds, const Gemm g, const Sched& S, const EpiT& E) {
    int tid_ = threadIdx.x; asm volatile("" : "+v"(tid_));
    const int tid = tid_, wid = __builtin_amdgcn_readfirstlane(tid >> 6), lane = tid & 63, wr = wid >> 2, wc = wid & 3, fr = lane & 15, fq = lane >> 4;
    const int K = g.K, nt = K / BK;
    unsigned voffA[2], voffB[2];
#pragma unroll
    for (int i = 0; i < 2; ++i) { int R, C; stage_rc(tid * 16 + i * 8192, R, C); const int Rb = EpiT::PERM ? ((R & ~31) + perm32(R & 31)) : R;
        voffA[i] = (unsigned)(R * K + C) * 2u; voffB[i] = (unsigned)(Rb * K + C) * 2u; }
    const size_t kstep = (size_t)(BK * 2);
    const size_t hstep = (size_t)HALF * K * 2;
    const size_t tstep = 2 * hstep;
    const unsigned ldsw = (unsigned)wid * 1024u;
    const int aoff = lds_byte(wr * 64 + fr, fq * 8), boff = lds_byte(wc * 32 + fr, fq * 8);
#define PG8_SA(b, h) (((b) * 2 + (h)) * HTB)
#define PG8_SB(b, h) ((4 + (b) * 2 + (h)) * HTB)
#define PG8_STAGE(bufoff, gbase, voff) do { _Pragma("unroll") for (int _i = 0; _i < 2; ++_i) \
        __builtin_amdgcn_global_load_lds((const unsigned*)((const char*)(gbase) + (voff)[_i]), (LAS unsigned*)(lds + (bufoff) + ldsw + _i * 8192), 16, 0, 0); } while (0)
#define PG8_LDA(dst, b, h) do { _Pragma("unroll") for (int m = 0; m < 4; ++m) _Pragma("unroll") for (int k = 0; k < 2; ++k) dst[m][k] = *(const LAS bf16x8*)(lds + PG8_SA(b, h) + aoff + m * 2048 + k * 1024); } while (0)
#define PG8_LDB(dst, b, h) do { _Pragma("unroll") for (int n = 0; n < 2; ++n) _Pragma("unroll") for (int k = 0; k < 2; ++k) dst[n][k] = *(const LAS bf16x8*)(lds + PG8_SB(b, h) + boff + n * 2048 + k * 1024); } while (0)
#define PG8_MMA(ai, bj, At, Bt) do { __builtin_amdgcn_s_setprio(1); _Pragma("unroll") for (int m = 0; m < 4; ++m) _Pragma("unroll") for (int n = 0; n < 2; ++n) _Pragma("unroll") for (int k = 0; k < 2; ++k) \
        acc[ai][bj][m][n] = __builtin_amdgcn_mfma_f32_16x16x32_bf16(Bt[n][k], At[m][k], acc[ai][bj][m][n], 0, 0, 0); __builtin_amdgcn_s_setprio(0); } while (0)
#define PG8_WAIT_V(n) asm volatile("s_waitcnt vmcnt(" #n ")" ::: "memory")
#define PG8_WAIT_L(n) asm volatile("s_waitcnt lgkmcnt(" #n ")" ::: "memory")
#define PG8_BAR __builtin_amdgcn_s_barrier()
#define PG8_SCHED __builtin_amdgcn_sched_barrier(0)
    Unit cur, nxt; int ui = 0;
    if (!S.next(0, cur)) return;
    f32x4 acc[2][2][4][2];
#pragma unroll
    for (int a = 0; a < 2; ++a)
#pragma unroll
        for (int b = 0; b < 2; ++b)
#pragma unroll
            for (int m = 0; m < 4; ++m)
#pragma unroll
                for (int n = 0; n < 2; ++n) acc[a][b][m][n] = (f32x4){0.f, 0.f, 0.f, 0.f};
    bf16x8 At[4][2], B0[2][2], B1[2][2];
    const char* cA = (const char*)g.A + (size_t)cur.pm * tstep; const char* cB = (const char*)g.Bt + (size_t)cur.pn * tstep;
    S.a_ready(cur);
    if constexpr (SP2) {
        PG8_STAGE(PG8_SB(0, 0), cB, voffB); PG8_STAGE(PG8_SB(0, 1), cB + hstep, voffB); PG8_STAGE(PG8_SA(0, 0), cA, voffA); PG8_STAGE(PG8_SA(0, 1), cA + hstep, voffA);
        if (wr == 1) PG8_BAR;
        PG8_WAIT_V(2); PG8_BAR;
        PG8_STAGE(PG8_SB(1, 0), cB + kstep, voffB); PG8_STAGE(PG8_SA(1, 0), cA + kstep, voffA); PG8_STAGE(PG8_SB(1, 1), cB + hstep + kstep, voffB);
        PG8_WAIT_V(6); PG8_BAR;
    } else {
        PG8_STAGE(PG8_SB(0, 0), cB, voffB); PG8_STAGE(PG8_SA(0, 0), cA, voffA); PG8_STAGE(PG8_SB(0, 1), cB + hstep, voffB); PG8_STAGE(PG8_SA(0, 1), cA + hstep, voffA);
        if (wr == 1) PG8_BAR;
        PG8_WAIT_V(4); PG8_BAR;
        PG8_STAGE(PG8_SB(1, 0), cB + kstep, voffB); PG8_STAGE(PG8_SA(1, 0), cA + kstep, voffA); PG8_STAGE(PG8_SB(1, 1), cB + hstep + kstep, voffB);
        PG8_WAIT_V(6); PG8_BAR;
    }
    for (;;) {
        const bool has_next = S.next(ui + 1, nxt);
        const char* nA = has_next ? (const char*)g.A + (size_t)nxt.pm * tstep : cA; const char* nB = has_next ? (const char*)g.Bt + (size_t)nxt.pn * tstep : cB;
        for (int t = 0; t < nt; t += 2) {
            const bool last = (t == nt - 2);
            const char* a1 = cA + (size_t)(t + 1) * kstep;
            const char* a2 = last ? nA : cA + (size_t)(t + 2) * kstep; const char* b2 = last ? nB : cB + (size_t)(t + 2) * kstep;
            const char* a3 = a2 + kstep; const char* b3 = b2 + kstep;
            if (last && has_next) S.a_ready(nxt);
            if constexpr (SP2) {
            PG8_LDB(B0, 0, 0); PG8_LDB(B1, 0, 1); PG8_SCHED; PG8_LDA(At, 0, 0); PG8_STAGE(PG8_SA(1, 1), a1 + hstep, voffA);
            PG8_WAIT_V(8); PG8_WAIT_L(0); PG8_BAR; PG8_MMA(0, 0, At, B0); PG8_MMA(0, 1, At, B1); PG8_BAR; PG8_SCHED;
            PG8_LDA(At, 0, 1); PG8_STAGE(PG8_SB(0, 0), b2, voffB); PG8_STAGE(PG8_SB(0, 1), b2 + hstep, voffB); PG8_STAGE(PG8_SA(0, 0), a2, voffA);
            PG8_WAIT_V(8); PG8_WAIT_L(0); PG8_BAR; PG8_MMA(1, 0, At, B0); PG8_MMA(1, 1, At, B1); PG8_BAR; PG8_SCHED;
            PG8_LDB(B0, 1, 0); PG8_LDB(B1, 1, 1); PG8_SCHED; PG8_LDA(At, 1, 0); PG8_STAGE(PG8_SA(0, 1), a2 + hstep, voffA);
            PG8_WAIT_V(8); PG8_WAIT_L(0); PG8_BAR; PG8_MMA(0, 0, At, B0); PG8_MMA(0, 1, At, B1); PG8_BAR; PG8_SCHED;
            PG8_LDA(At, 1, 1); PG8_STAGE(PG8_SB(1, 0), b3, voffB); PG8_STAGE(PG8_SB(1, 1), b3 + hstep, voffB); PG8_STAGE(PG8_SA(1, 0), a3, voffA);
            PG8_WAIT_V(8); PG8_WAIT_L(0); PG8_BAR; PG8_MMA(1, 0, At, B0); PG8_MMA(1, 1, At, B1); PG8_BAR; PG8_SCHED;
            } else {
            PG8_LDB(B0, 0, 0); PG8_SCHED; PG8_LDA(At, 0, 0); PG8_STAGE(PG8_SA(1, 1), a1 + hstep, voffA);
            PG8_WAIT_L(8); PG8_BAR; PG8_WAIT_L(0); PG8_MMA(0, 0, At, B0); PG8_BAR; PG8_SCHED;
            PG8_LDB(B1, 0, 1); PG8_STAGE(PG8_SB(0, 0), b2, voffB);
            PG8_BAR; PG8_WAIT_L(0); PG8_MMA(0, 1, At, B1); PG8_BAR;
            PG8_LDA(At, 0, 1); PG8_STAGE(PG8_SA(0, 0), a2, voffA);
            PG8_BAR; PG8_WAIT_L(0); PG8_MMA(1, 0, At, B0); PG8_BAR; PG8_SCHED;
            PG8_STAGE(PG8_SB(0, 1), b2 + hstep, voffB);
            PG8_WAIT_V(6); PG8_BAR; PG8_MMA(1, 1, At, B1); PG8_BAR;
            PG8_LDB(B0, 1, 0); PG8_SCHED; PG8_LDA(At, 1, 0); PG8_STAGE(PG8_SA(0, 1), a2 + hstep, voffA);
            PG8_WAIT_L(8); PG8_BAR; PG8_WAIT_L(0); PG8_MMA(0, 0, At, B0); PG8_BAR; PG8_SCHED;
            PG8_LDB(B1, 1, 1); PG8_STAGE(PG8_SB(1, 0), b3, voffB);
            PG8_BAR; PG8_WAIT_L(0); PG8_MMA(0, 1, At, B1); PG8_BAR;
            PG8_LDA(At, 1, 1); PG8_STAGE(PG8_SA(1, 0), a3, voffA);
            PG8_BAR; PG8_WAIT_L(0); PG8_MMA(1, 0, At, B0); PG8_BAR; PG8_SCHED;
            PG8_STAGE(PG8_SB(1, 1), b3 + hstep, voffB);
            PG8_WAIT_V(6); PG8_BAR; PG8_MMA(1, 1, At, B1); PG8_BAR;
            }
        }
        if constexpr (ALIGN_EPI) { if (wr == 0) PG8_BAR; }
        if constexpr (!EpiT::AFTER_DRAIN) { E(acc, cur, wr, wc, fr, fq); S.done(cur); }
        if (!has_next) break;
#pragma unroll
        for (int a = 0; a < 2; ++a)
#pragma unroll
            for (int b = 0; b < 2; ++b)
#pragma unroll
                for (int m = 0; m < 4; ++m)
#pragma unroll
                    for (int n = 0; n < 2; ++n) acc[a][b][m][n] = (f32x4){0.f, 0.f, 0.f, 0.f};
        cur = nxt; cA = nA; cB = nB; ++ui;
        if constexpr (ALIGN_EPI) { if (wr == 1) PG8_BAR; }
    }
    PG8_WAIT_V(0);
    if constexpr (!ALIGN_EPI) { if (wr == 0) PG8_BAR; }
    PG8_BAR;
#undef PG8_SA
#undef PG8_SB
#undef PG8_STAGE
#undef PG8_LDA
#undef PG8_LDB
#undef PG8_MMA
#undef PG8_WAIT_V
#undef PG8_WAIT_L
#undef PG8_BAR
#undef PG8_SCHED
}
}

struct Params {
    const float* in[21];
    float* out;
    unsigned char* ws;
    int ph_lo, ph_hi;
};
enum { I_XP = 0, I_XS, I_RELB, I_GPRE, I_WIN, I_LQ1, I_LK1, I_LQ2, I_LK2, I_GSUB, I_LBF, I_LBB, I_GHO, I_WPA, I_WPB, I_WOUT, I_GPOST, I_GMPRE, I_WUP, I_WDN, I_GMPOST };

constexpr int LDS_BYTES = 151552;

__device__ __forceinline__ float wave_sum(float v) {
#pragma unroll
    for (int o = 1; o < 64; o <<= 1) v += __shfl_xor(v, o);
    return v;
}
__device__ __forceinline__ float half_sum(float v) {
#pragma unroll
    for (int o = 1; o < 32; o <<= 1) v += __shfl_xor(v, o);
    return v;
}

__device__ __forceinline__ void p0_transpose_item(const float* W, int K, int N, bf16_t* WT, LAS float* scr, int item, int lane, bool scale_q) {
    const int nblk = N / 32, kb = item / nblk, nb = item % nblk, k0 = 64 * kb, n0 = 32 * nb;
    const float sc = (scale_q && n0 < 1024) ? QSCALE : 1.f;
#pragma unroll 8
    for (int i = 0; i < 32; ++i) { const int kk = 2 * i + (lane >> 5); scr[kk * 33 + (lane & 31)] = W[(size_t)(k0 + kk) * N + n0 + (lane & 31)] * sc; }
    asm volatile("s_waitcnt lgkmcnt(0)" ::: "memory");
    const int c = lane & 7;
#pragma unroll
    for (int j = 0; j < 4; ++j) { const int n = (lane >> 3) + 8 * j; const LAS float* s = scr + (8 * c) * 33 + n;
        u32x4 o; o.x = cvtpk(s[0 * 33], s[1 * 33]); o.y = cvtpk(s[2 * 33], s[3 * 33]); o.z = cvtpk(s[4 * 33], s[5 * 33]); o.w = cvtpk(s[6 * 33], s[7 * 33]);
        *(u32x4*)(WT + (size_t)(n0 + n) * K + k0 + 8 * c) = o; }
    asm volatile("s_waitcnt lgkmcnt(0)" ::: "memory");
}

__device__ __forceinline__ void row_prenorm(const float* xrow, const float* g, bf16_t* orow, int lane) {
    f32x4 v[4]; float s = 0.f;
#pragma unroll
    for (int j = 0; j < 4; ++j) { v[j] = *(const f32x4*)(xrow + 4 * lane + 256 * j); s += (v[j].x * v[j].x + v[j].y * v[j].y) + (v[j].z * v[j].z + v[j].w * v[j].w); }
    const float r = 1.f / sqrtf(wave_sum(s) * (1.f / D) + EPS);
#pragma unroll
    for (int j = 0; j < 4; ++j) { const f32x4 gg = *(const f32x4*)(g + 4 * lane + 256 * j);
        u32x2 w; w.x = cvtpk(v[j].x * r * gg.x, v[j].y * r * gg.y); w.y = cvtpk(v[j].z * r * gg.z, v[j].w * r * gg.w);
        *(u32x2*)(orow + 4 * lane + 256 * j) = w; }
}
__device__ __forceinline__ void row_normres1(const float* xrow, const bf16_t* yrow, const float* g1, const float* g2, float* outrow, bf16_t* hrow, int lane) {
    f32x4 y[4]; float s = 0.f;
#pragma unroll
    for (int j = 0; j < 4; ++j) { const u32x2 w = *(const u32x2*)(yrow + 4 * lane + 256 * j);
        y[j] = (f32x4){bf2f(w.x & 0xffffu), bf2f(w.x >> 16), bf2f(w.y & 0xffffu), bf2f(w.y >> 16)};
        s += (y[j].x * y[j].x + y[j].y * y[j].y) + (y[j].z * y[j].z + y[j].w * y[j].w); }
    const float r = 1.f / sqrtf(wave_sum(s) * (1.f / D) + EPS);
    float s2 = 0.f;
#pragma unroll
    for (int j = 0; j < 4; ++j) { const f32x4 xx = *(const f32x4*)(xrow + 4 * lane + 256 * j); const f32x4 gg = *(const f32x4*)(g1 + 4 * lane + 256 * j);
        y[j] = xx + y[j] * r * gg; *(f32x4*)(outrow + 4 * lane + 256 * j) = y[j];
        s2 += (y[j].x * y[j].x + y[j].y * y[j].y) + (y[j].z * y[j].z + y[j].w * y[j].w); }
    const float r2 = 1.f / sqrtf(wave_sum(s2) * (1.f / D) + EPS);
#pragma unroll
    for (int j = 0; j < 4; ++j) { const f32x4 gg = *(const f32x4*)(g2 + 4 * lane + 256 * j);
        u32x2 w; w.x = cvtpk(y[j].x * r2 * gg.x, y[j].y * r2 * gg.y); w.y = cvtpk(y[j].z * r2 * gg.z, y[j].w * r2 * gg.w);
        *(u32x2*)(hrow + 4 * lane + 256 * j) = w; }
}
__device__ __forceinline__ void row_final(const bf16_t* yrow, const float* g, float* outrow, int lane) {
    f32x4 y[4]; float s = 0.f;
#pragma unroll
    for (int j = 0; j < 4; ++j) { const u32x2 w = *(const u32x2*)(yrow + 4 * lane + 256 * j);
        y[j] = (f32x4){bf2f(w.x & 0xffffu), bf2f(w.x >> 16), bf2f(w.y & 0xffffu), bf2f(w.y >> 16)};
        s += (y[j].x * y[j].x + y[j].y * y[j].y) + (y[j].z * y[j].z + y[j].w * y[j].w); }
    const float r = 1.f / sqrtf(wave_sum(s) * (1.f / D) + EPS);
#pragma unroll
    for (int j = 0; j < 4; ++j) { const f32x4 xx = *(const f32x4*)(outrow + 4 * lane + 256 * j); const f32x4 gg = *(const f32x4*)(g + 4 * lane + 256 * j);
        *(f32x4*)(outrow + 4 * lane + 256 * j) = xx + y[j] * r * gg; }
}
__device__ __forceinline__ void row_hgrn_fin(const float* of, const float* ob, const bf16_t* ogrow, const float* gout, bf16_t* orow, int lane) {
#pragma unroll
    for (int j = 0; j < 4; ++j) {
        const int col = 4 * lane + 256 * j;
        f32x4 v = *(const f32x4*)(of + col) + *(const f32x4*)(ob + col);
        const float ss = half_sum((v.x * v.x + v.y * v.y) + (v.z * v.z + v.w * v.w));
        const float r = 1.f / sqrtf(ss * (1.f / 128.f) + EPS);
        const f32x4 gg = *(const f32x4*)(gout + (col & 127));
        const u32x2 w = *(const u32x2*)(ogrow + col);
        const float g0 = bf2f(w.x & 0xffffu), g1 = bf2f(w.x >> 16), g2 = bf2f(w.y & 0xffffu), g3 = bf2f(w.y >> 16);
        u32x2 o; o.x = cvtpk(v.x * r * gg.x * g0 * sigmoidf_(g0), v.y * r * gg.y * g1 * sigmoidf_(g1));
        o.y = cvtpk(v.z * r * gg.z * g2 * sigmoidf_(g2), v.w * r * gg.w * g3 * sigmoidf_(g3));
        *(u32x2*)(orow + col) = o;
    }
}

constexpr int AT_K0 = 0, AT_V0 = 16384, AT_TAB = 49152;
__device__ __forceinline__ int t5_bucket_dev(int rel) {
    const int n = rel < 0 ? -rel : rel; const int ret = rel > 0 ? 16 : 0;
    int b;
    if (n < 8) b = n; else if (n < 12) b = 8; else if (n < 16) b = 9; else if (n < 23) b = 10; else if (n < 32) b = 11; else if (n < 46) b = 12; else if (n < 64) b = 13; else if (n < 91) b = 14; else b = 15;
    return ret + b;
}
__device__ __forceinline__ void attn_item(LAS unsigned char* lds, const bf16_t* proj, const bf16_t* vT, bf16_t* oa, float* stash, const float* relb, const float* gsub, float lam,
                                          int s, int h, int qb, int T) {
    int tid_ = threadIdx.x; asm volatile("" : "+v"(tid_));
    const int tid = tid_, lane = tid & 63, r32 = lane & 31, hi = lane >> 5; const int wid = __builtin_amdgcn_readfirstlane(tid >> 6);
    const int NT = T / 64;
    const size_t rowbase = (size_t)s * T;
    LAS float* tab = (LAS float*)(lds + AT_TAB);
    __syncthreads();
    for (int i = tid; i < 257; i += 512) tab[i] = relb[t5_bucket_dev(i - 128) * 8 + h] * LOG2E;
    const float cL = relb[15 * 8 + h] * LOG2E, cR = relb[31 * 8 + h] * LOG2E;
    const int qlo = qb * 256 + wid * 32;
    const size_t qrow = rowbase + qlo + r32;
    const int kkey = tid >> 3, kch = tid & 7;
    const unsigned kdst = (kch >> 1) * 2048 + (kch & 1) * 1024 + (kkey >> 5) * 512 + (kkey & 31) * 16;
    unsigned vdst[2]; const bf16_t* vsrc[2];
#pragma unroll
    for (int i = 0; i < 2; ++i) { const int idx = tid + 512 * i, dv = idx >> 3, ch = idx & 7;
        vdst[i] = ((dv >> 5) * 4 + (ch >> 1)) * 1024 + (ch & 1) * 512 + (dv & 31) * 16;
        vsrc[i] = vT + ((size_t)(s * 8 + h) * 128 + dv) * T + ch * 8; }
    float* st = stash + ((size_t)blockIdx.x * 512 + tid) * 64;
#pragma unroll 1
    for (int c = 0; c < 2; ++c) {
        bf16x8 qr[4];
#pragma unroll
        for (int d0 = 0; d0 < 4; ++d0) qr[d0] = *(const bf16x8*)(proj + qrow * NPROJ + C_AQ + h * 128 + c * 64 + 16 * d0 + 8 * hi);
        const bf16_t* ksrc = proj + (rowbase + kkey) * NPROJ + C_AK + h * 128 + c * 64 + kch * 8;
        f32x16 o[4];
#pragma unroll
        for (int i = 0; i < 4; ++i)
#pragma unroll
            for (int r = 0; r < 16; ++r) o[i][r] = 0.f;
        float l = 0.f;
        __syncthreads();
        {
            const u32x4 kreg = *(const u32x4*)(ksrc);
            const u32x4 v0 = *(const u32x4*)(vsrc[0]), v1 = *(const u32x4*)(vsrc[1]);
            *(LAS u32x4*)(lds + AT_K0 + kdst) = kreg; *(LAS u32x4*)(lds + AT_V0 + vdst[0]) = v0; *(LAS u32x4*)(lds + AT_V0 + vdst[1]) = v1;
        }
        __syncthreads();
#pragma unroll 1
        for (int kt = 0; kt < NT; ++kt) {
            const int cur = kt & 1; const bool more = (kt + 1 < NT);
            u32x4 kreg, v0, v1;
            if (more) { kreg = *(const u32x4*)(ksrc + (size_t)(kt + 1) * 64 * NPROJ); v0 = *(const u32x4*)(vsrc[0] + (kt + 1) * 64); v1 = *(const u32x4*)(vsrc[1] + (kt + 1) * 64); }
            const LAS unsigned char* Kb = lds + AT_K0 + cur * 8192; const LAS unsigned char* Vb = lds + AT_V0 + cur * 16384;
            f32x16 p0, p1;
#pragma unroll
            for (int r = 0; r < 16; ++r) { p0[r] = 0.f; p1[r] = 0.f; }
#pragma unroll
            for (int d0 = 0; d0 < 4; ++d0) {
                const bf16x8 a0 = *(const LAS bf16x8*)(Kb + d0 * 2048 + hi * 1024 + r32 * 16);
                const bf16x8 a1 = *(const LAS bf16x8*)(Kb + d0 * 2048 + hi * 1024 + 512 + r32 * 16);
                p0 = __builtin_amdgcn_mfma_f32_32x32x16_bf16(a0, qr[d0], p0, 0, 0, 0);
                p1 = __builtin_amdgcn_mfma_f32_32x32x16_bf16(a1, qr[d0], p1, 0, 0, 0);
            }
            __builtin_amdgcn_sched_barrier(0);
            const int k0 = kt * 64;
            if (k0 - (qlo + 31) >= 128) {
#pragma unroll
                for (int r = 0; r < 16; ++r) { p0[r] = fexp2(p0[r] + cR); p1[r] = fexp2(p1[r] + cR); }
            } else if (k0 + 63 - qlo <= -128) {
#pragma unroll
                for (int r = 0; r < 16; ++r) { p0[r] = fexp2(p0[r] + cL); p1[r] = fexp2(p1[r] + cL); }
            } else {
                const int qpos = qlo + r32;
#pragma unroll
                for (int r = 0; r < 16; ++r) {
                    const int rel0 = k0 + crow(r, hi) - qpos, rel1 = rel0 + 32;
                    const int i0 = min(max(rel0, -128), 128) + 128, i1 = min(max(rel1, -128), 128) + 128;
                    p0[r] = fexp2(p0[r] + tab[i0]); p1[r] = fexp2(p1[r] + tab[i1]);
                }
            }
            float sa = 0.f, sb = 0.f;
#pragma unroll
            for (int r = 0; r < 16; ++r) { sa += p0[r]; sb += p1[r]; }
            l += sa + sb;
            u32x4 pw[4];
#pragma unroll
            for (int i = 0; i < 4; ++i) { pw[0][i] = cvtpk(p0[2 * i], p0[2 * i + 1]); pw[1][i] = cvtpk(p0[8 + 2 * i], p0[8 + 2 * i + 1]);
                                          pw[2][i] = cvtpk(p1[2 * i], p1[2 * i + 1]); pw[3][i] = cvtpk(p1[8 + 2 * i], p1[8 + 2 * i + 1]); }
            __builtin_amdgcn_sched_barrier(0);
#pragma unroll
            for (int ks = 0; ks < 4; ++ks) {
#pragma unroll
                for (int dvb = 0; dvb < 4; ++dvb) {
                    const bf16x8 vf = *(const LAS bf16x8*)(Vb + (dvb * 4 + ks) * 1024 + hi * 512 + r32 * 16);
                    o[dvb] = __builtin_amdgcn_mfma_f32_32x32x16_bf16(vf, __builtin_bit_cast(bf16x8, pw[ks]), o[dvb], 0, 0, 0);
                }
                __builtin_amdgcn_sched_barrier(0);
            }
            if (more) { const int nx = cur ^ 1;
                *(LAS u32x4*)(lds + AT_K0 + nx * 8192 + kdst) = kreg; *(LAS u32x4*)(lds + AT_V0 + nx * 16384 + vdst[0]) = v0; *(LAS u32x4*)(lds + AT_V0 + nx * 16384 + vdst[1]) = v1; }
            __syncthreads();
        }
        l += __shfl_xor(l, 32);
        const float rl = 1.f / l;
        if (c == 0) {
#pragma unroll
            for (int i = 0; i < 4; ++i)
#pragma unroll
                for (int g = 0; g < 4; ++g) *(f32x4*)(st + i * 16 + 4 * g) = (f32x4){o[i][4 * g] * rl, o[i][4 * g + 1] * rl, o[i][4 * g + 2] * rl, o[i][4 * g + 3] * rl};
        } else {
            float ss = 0.f;
#pragma unroll
            for (int i = 0; i < 4; ++i)
#pragma unroll
                for (int g = 0; g < 4; ++g) { const f32x4 s0 = *(const f32x4*)(st + i * 16 + 4 * g);
#pragma unroll
                    for (int j = 0; j < 4; ++j) { const float v = s0[j] - lam * (o[i][4 * g + j] * rl); o[i][4 * g + j] = v; ss += v * v; } }
            ss += __shfl_xor(ss, 32);
            const float rn = 0.8f / sqrtf(ss * (1.f / 128.f) + EPS);
            bf16_t* orow = oa + qrow * D + h * 128;
#pragma unroll
            for (int i = 0; i < 4; ++i)
#pragma unroll
                for (int g = 0; g < 4; ++g) { const int dv = 32 * i + 8 * g + 4 * hi; const f32x4 gg = *(const f32x4*)(gsub + dv);
                    u32x2 w; w.x = cvtpk(o[i][4 * g] * rn * gg.x, o[i][4 * g + 1] * rn * gg.y); w.y = cvtpk(o[i][4 * g + 2] * rn * gg.z, o[i][4 * g + 3] * rn * gg.w);
                    *(u32x2*)(orow + dv) = w; }
        }
    }
}

constexpr int HG_QT = 0, HG_KT = 17408, HG_KTT = 34816, HG_VT = 53248, HG_DIR = 71680;
constexpr int HG_HS = 2 * HG_DIR;
constexpr int HG_EC = HG_HS + 2048, HG_EL = HG_EC + 1024;
static_assert(HG_EL + 1024 <= LDS_BYTES, "HGRN LDS map");
__device__ __forceinline__ void hgrn_chain(LAS unsigned char* lds, const bf16_t* proj, float* opart, const float* lbfw, const float* lbbw, int s, int h, int T) {
    int tid_ = threadIdx.x; asm volatile("" : "+v"(tid_));
    const int tid = tid_, lane = tid & 63, r32 = lane & 31, hi = lane >> 5; const int wid = __builtin_amdgcn_readfirstlane(tid >> 6);
    const int d = tid >> 8, k = tid & 127, half = (tid >> 7) & 1;
    const int dw = wid >> 2, dvb = wid & 3;
    LAS unsigned char* L = lds + d * HG_DIR;
    LAS float* hs = (LAS float*)(lds + HG_HS); LAS float* ec = (LAS float*)(lds + HG_EC); LAS float* el = (LAS float*)(lds + HG_EL);
    const float* lbw = d ? lbbw : lbfw;
    const float lb = sigmoidf_(lbw[h * 128 + k] - lbw[1024 + h * 128 + k]);
    const float omlb = 1.f - lb;
    const size_t rowbase = (size_t)s * T;
    const int zcol = (d ? C_GFB : C_GFF) + h * 128 + k, qcol = C_GQ + h * 128 + k, vcol = C_GI + h * 128 + k;
    f32x16 S[4];
#pragma unroll
    for (int i = 0; i < 4; ++i)
#pragma unroll
        for (int r = 0; r < 16; ++r) S[i][r] = 0.f;
    const int NC = T / 64;
    __syncthreads();
#pragma unroll 1
    for (int c = 0; c < NC; ++c) {
        float g2[32], kk[32]; unsigned qv[32];
        float run = 0.f;
        {
            unsigned zr[32], vr[32];
#pragma unroll
            for (int ii = 0; ii < 32; ++ii) { const int i = 32 * half + ii; const int tk = d ? (T - 1 - (64 * c + i)) : (64 * c + i); const bf16_t* rp = proj + (rowbase + tk) * NPROJ;
                zr[ii] = rp[zcol]; qv[ii] = rp[qcol]; vr[ii] = rp[vcol]; }
#pragma unroll
            for (int q4 = 0; q4 < 4; ++q4) { u32x4 w;
#pragma unroll
                for (int e = 0; e < 4; ++e) w[e] = vr[8 * q4 + 2 * e] | (vr[8 * q4 + 2 * e + 1] << 16);
                *(LAS u32x4*)(L + HG_VT + k * 144 + (32 * half + 8 * q4) * 2) = w; }
#pragma unroll
            for (int ii = 0; ii < 32; ++ii) { const float z = bf2f(zr[ii]); const float sg = sigmoidf_(z); const float f = lb + omlb * sg;
                kk[ii] = omlb * (1.f - sg); run += flog2(f); g2[ii] = run; }
        }
        hs[(d * 2 + half) * 128 + k] = run;
        __syncthreads();
        const float cref = hs[(d * 2 + 0) * 128 + k];
        const float blast = cref + hs[(d * 2 + 1) * 128 + k];
        const float boff = half ? cref : 0.f;
        if (half == 0) { ec[d * 128 + k] = fexp2(cref); el[d * 128 + k] = fexp2(blast - cref); }
        {
            unsigned ktt[32];
#pragma unroll
            for (int ii = 0; ii < 32; ++ii) { const int i = 32 * half + ii; const float bb = g2[ii] + boff - cref;
                const float e1 = fexp2(fminf(bb, 100.f)), e2 = fexp2(fminf(-bb, 100.f));
                const bf16_t qt = f2bf(bf2f(qv[ii]) * e1), kt = f2bf(kk[ii] * e2);
                *(LAS bf16_t*)(L + HG_QT + i * 272 + k * 2) = qt; *(LAS bf16_t*)(L + HG_KT + i * 272 + k * 2) = kt; ktt[ii] = kt; }
#pragma unroll
            for (int q4 = 0; q4 < 4; ++q4) { u32x4 w;
#pragma unroll
                for (int e = 0; e < 4; ++e) w[e] = ktt[8 * q4 + 2 * e] | (ktt[8 * q4 + 2 * e + 1] << 16);
                *(LAS u32x4*)(L + HG_KTT + k * 144 + (32 * half + 8 * q4) * 2) = w; }
        }
        __syncthreads();
        f32x16 am;
#pragma unroll
        for (int r = 0; r < 16; ++r) am[r] = 0.f;
        const int tb = (dvb == 0 || dvb == 3) ? 0 : 1, sb = (dvb >= 2) ? 1 : 0;
        if (dvb < 3) {
#pragma unroll
            for (int ks = 0; ks < 8; ++ks) {
                const bf16x8 a = *(const LAS bf16x8*)(L + HG_QT + (32 * tb + r32) * 272 + (16 * ks + 8 * hi) * 2);
                const bf16x8 b = *(const LAS bf16x8*)(L + HG_KT + (32 * sb + r32) * 272 + (16 * ks + 8 * hi) * 2);
                am = __builtin_amdgcn_mfma_f32_32x32x16_bf16(a, b, am, 0, 0, 0);
            }
        }
        __syncthreads();
#pragma unroll
        for (int r = 0; r < 16; ++r) { const int t = 32 * tb + crow(r, hi), sc = 32 * sb + r32; const float v = (sc <= t) ? am[r] : 0.f;
            *(LAS bf16_t*)(L + HG_KT + t * 272 + sc * 2) = f2bf(v); }
        __syncthreads();
        f32x16 o[2];
#pragma unroll
        for (int i = 0; i < 2; ++i)
#pragma unroll
            for (int r = 0; r < 16; ++r) o[i][r] = 0.f;
#pragma unroll
        for (int kb = 0; kb < 4; ++kb) {
#pragma unroll
            for (int r = 0; r < 16; ++r) S[kb][r] *= ec[dw * 128 + 32 * kb + crow(r, hi)];
#pragma unroll
            for (int sp = 0; sp < 2; ++sp) {
                u32x4 pw;
#pragma unroll
                for (int i = 0; i < 4; ++i) pw[i] = cvtpk(S[kb][8 * sp + 2 * i], S[kb][8 * sp + 2 * i + 1]);
#pragma unroll
                for (int tb2 = 0; tb2 < 2; ++tb2) {
                    const LAS unsigned char* qp = L + HG_QT + (32 * tb2 + r32) * 272 + (32 * kb + 16 * sp + 4 * hi) * 2;
                    const u32x2 lo = *(const LAS u32x2*)(qp), hi2 = *(const LAS u32x2*)(qp + 16);
                    const u32x4 af = {lo.x, lo.y, hi2.x, hi2.y};
                    o[tb2] = __builtin_amdgcn_mfma_f32_32x32x16_bf16(__builtin_bit_cast(bf16x8, af), __builtin_bit_cast(bf16x8, pw), o[tb2], 0, 0, 0);
                }
            }
        }
#pragma unroll
        for (int ks = 0; ks < 4; ++ks) {
            const bf16x8 vf = *(const LAS bf16x8*)(L + HG_VT + (32 * dvb + r32) * 144 + (16 * ks + 8 * hi) * 2);
#pragma unroll
            for (int tb2 = 0; tb2 < 2; ++tb2) {
                const bf16x8 af = *(const LAS bf16x8*)(L + HG_KT + (32 * tb2 + r32) * 272 + (16 * ks + 8 * hi) * 2);
                o[tb2] = __builtin_amdgcn_mfma_f32_32x32x16_bf16(af, vf, o[tb2], 0, 0, 0);
            }
#pragma unroll
            for (int kb = 0; kb < 4; ++kb) {
                const bf16x8 kf = *(const LAS bf16x8*)(L + HG_KTT + (32 * kb + r32) * 144 + (16 * ks + 8 * hi) * 2);
                S[kb] = __builtin_amdgcn_mfma_f32_32x32x16_bf16(kf, vf, S[kb], 0, 0, 0);
            }
        }
#pragma unroll
        for (int kb = 0; kb < 4; ++kb)
#pragma unroll
            for (int r = 0; r < 16; ++r) S[kb][r] *= el[dw * 128 + 32 * kb + crow(r, hi)];
        float* op = opart + (size_t)dw * MR * D;
#pragma unroll
        for (int tb2 = 0; tb2 < 2; ++tb2)
#pragma unroll
            for (int r = 0; r < 16; ++r) { const int i = 32 * tb2 + crow(r, hi); const int tk = dw ? (T - 1 - (64 * c + i)) : (64 * c + i);
                op[(rowbase + tk) * D + h * 128 + 32 * dvb + r32] = o[tb2][r]; }
        __syncthreads();
    }
}


__global__ void __launch_bounds__(512) fwd_kernel(Params p) {
    extern __shared__ __attribute__((aligned(16))) unsigned char lds_raw[];
    LAS unsigned char* lds = (LAS unsigned char*)lds_raw;
    const int G = gridDim.x, bid = blockIdx.x;
    const int NGW = G * 8;
#define PHASE_IDS int tid = threadIdx.x; asm volatile("" : "+v"(tid)); const int lane = tid & 63; const int wave = __builtin_amdgcn_readfirstlane(tid >> 6); const int gw = bid * 8 + wave; (void)lane; (void)gw;
    unsigned char* ws = p.ws;
    unsigned* ctl = (unsigned*)(ws + WS_CTL);
    bf16_t* Win_t = (bf16_t*)(ws + WS_WIN); bf16_t* Wa_t = (bf16_t*)(ws + WS_WA); bf16_t* Wb_t = (bf16_t*)(ws + WS_WB); bf16_t* Wout_t = (bf16_t*)(ws + WS_WOUT);
    bf16_t* Wup_t = (bf16_t*)(ws + WS_WUP); bf16_t* Wdn_t = (bf16_t*)(ws + WS_WDN);
    bf16_t* HB = (bf16_t*)(ws + WS_HB); bf16_t* PROJ = (bf16_t*)(ws + WS_PROJ); bf16_t* U = (bf16_t*)(ws + WS_U); bf16_t* VT = (bf16_t*)(ws + WS_VT);
    bf16_t* OA = (bf16_t*)(ws + WS_OA); bf16_t* OB = (bf16_t*)(ws + WS_OB); bf16_t* MERGED = (bf16_t*)(ws + WS_MERGED); bf16_t* Y = (bf16_t*)(ws + WS_Y);
    float* OPART = (float*)(ws + WS_OPART); float* STASH = (float*)(ws + WS_STASH);
#if N_LAUNCH_MODE == 1
    cg::grid_group grid = cg::this_grid();
#define GRID_SYNC() grid.sync()
#else
#define GRID_SYNC() do {} while (0)
#endif
    const int lo = p.ph_lo, hi = p.ph_hi;
    int ph = 0;
#define RUN_PHASE (ph >= lo && ph < hi)
#define END_PHASE do { ++ph; if (ph > lo && ph < hi) GRID_SYNC(); } while (0)

    if (RUN_PHASE) { PHASE_IDS
        if (bid == 0 && tid < 64) ctl[tid] = 0u;
        LAS float* scr = (LAS float*)(lds + wave * 16384);
        constexpr int I_IN = (D / 64) * (NPROJ / 32), I_SQ = (D / 64) * (D / 32), I_UP = (D / 64) * (FF / 32), I_DN = (FF / 64) * (D / 32);
        constexpr int NITEMS = I_IN + 3 * I_SQ + I_UP + I_DN;
        for (int it = gw; it < NITEMS; it += NGW) {
            int r = it;
            if (r < I_IN) { p0_transpose_item(p.in[I_WIN], D, NPROJ, Win_t, scr, r, lane, true); continue; } r -= I_IN;
            if (r < I_SQ) { p0_transpose_item(p.in[I_WPA], D, D, Wa_t, scr, r, lane, false); continue; } r -= I_SQ;
            if (r < I_SQ) { p0_transpose_item(p.in[I_WPB], D, D, Wb_t, scr, r, lane, false); continue; } r -= I_SQ;
            if (r < I_SQ) { p0_transpose_item(p.in[I_WOUT], D, D, Wout_t, scr, r, lane, false); continue; } r -= I_SQ;
            if (r < I_UP) { p0_transpose_item(p.in[I_WUP], D, FF, Wup_t, scr, r, lane, false); continue; } r -= I_UP;
            p0_transpose_item(p.in[I_WDN], FF, D, Wdn_t, scr, r, lane, false);
        }
        for (int m = gw; m < MR; m += NGW) row_prenorm(p.in[I_XP] + (size_t)m * D, p.in[I_GPRE], HB + (size_t)m * D, lane);
    }
    END_PHASE;

#pragma unroll 1
    for (int rnd = 0; rnd < NROUND; ++rnd) {
        const int T = rnd == 0 ? 4096 : 8192; const int nseq = MR / T;
        const float* xr = rnd == 0 ? p.in[I_XP] : p.in[I_XS] + (size_t)(rnd - 1) * MR * D;
        float* outr = p.out + (size_t)rnd * MR * D;
        if (RUN_PHASE) {
            pg8::Gemm g{HB, Win_t, MR, NPROJ, D}; pg8::StaticOrder S; S.init(MR, NPROJ, G, bid);
            pg8::Epi<1> E{PROJ, NPROJ, nullptr, 0, 0, VT, T};
            pg8::gemm_phase<pg8::Epi<1>, pg8::StaticOrder, true, true>(lds, g, S, E);
        }
        END_PHASE;
        if (RUN_PHASE) { PHASE_IDS
#ifndef NO_HGRN
            if (bid < nseq * 8) hgrn_chain(lds, PROJ, OPART, p.in[I_LBF], p.in[I_LBB], bid / 8, bid % 8, T);
#endif
            float lam;
            { float a = p.in[I_LQ1][lane] * p.in[I_LK1][lane], b = p.in[I_LQ2][lane] * p.in[I_LK2][lane]; a = wave_sum(a); b = wave_sum(b); lam = expf(a) - expf(b) + 0.2f; }
            const int nqb = T / 256, nitems = nseq * 8 * nqb;
            LAS int* slot = (LAS int*)(lds + AT_TAB + 2048);
            for (;;) {
                __syncthreads();
                if (tid == 0) *slot = (int)atomicAdd(&ctl[rnd], 1u);
                __syncthreads();
                const int it = *slot;
                if (it >= nitems) break;
                const int qb = it % nqb, sh = it / nqb;
#ifndef NO_ATTN
                attn_item(lds, PROJ, VT, OA, STASH, p.in[I_RELB], p.in[I_GSUB], lam, sh / 8, sh % 8, qb, T);
#endif
            }
        }
        END_PHASE;
        if (RUN_PHASE) { PHASE_IDS
            pg8::Gemm g{OA, Wa_t, MR, D, D}; pg8::StaticOrder S; S.init(MR, D, G, bid);
            pg8::Epi<2> E{MERGED, D, PROJ, NPROJ, C_GA, nullptr, 0};
            pg8::gemm_phase<pg8::Epi<2>, pg8::StaticOrder, true, true>(lds, g, S, E);
            for (int m = gw; m < MR; m += NGW)
                row_hgrn_fin(OPART + (size_t)m * D, OPART + (size_t)MR * D + (size_t)m * D, PROJ + (size_t)m * NPROJ + C_GOG, p.in[I_GHO], OB + (size_t)m * D, lane);
        }
        END_PHASE;
        if (RUN_PHASE) {
            pg8::Gemm g{OB, Wb_t, MR, D, D}; pg8::StaticOrder S; S.init(MR, D, G, bid);
            pg8::Epi<3> E{MERGED, D, PROJ, NPROJ, C_GB, nullptr, 0};
            pg8::gemm_phase<pg8::Epi<3>, pg8::StaticOrder, true, true>(lds, g, S, E);
        }
        END_PHASE;
        if (RUN_PHASE) {
            pg8::Gemm g{MERGED, Wout_t, MR, D, D}; pg8::StaticOrder S; S.init(MR, D, G, bid);
            pg8::Epi<0> E{Y, D, nullptr, 0, 0, nullptr, 0};
            pg8::gemm_phase<pg8::Epi<0>, pg8::StaticOrder, true, true>(lds, g, S, E);
        }
        END_PHASE;
        if (RUN_PHASE) { PHASE_IDS
            for (int m = gw; m < MR; m += NGW)
                row_normres1(xr + (size_t)m * D, Y + (size_t)m * D, p.in[I_GPOST], p.in[I_GMPRE], outr + (size_t)m * D, HB + (size_t)m * D, lane);
        }
        END_PHASE;
        if (RUN_PHASE) {
            pg8::Gemm g{HB, Wup_t, MR, FF, D}; pg8::StaticOrder S; S.init(MR, FF, G, bid);
            pg8::Epi<4> E{U, FF, nullptr, 0, 0, nullptr, 0};
            pg8::gemm_phase<pg8::Epi<4>, pg8::StaticOrder, true, true>(lds, g, S, E);
        }
        END_PHASE;
        if (RUN_PHASE) {
            pg8::Gemm g{U, Wdn_t, MR, D, FF}; pg8::StaticOrder S; S.init(MR, D, G, bid);
            pg8::Epi<0> E{Y, D, nullptr, 0, 0, nullptr, 0};
            pg8::gemm_phase<pg8::Epi<0>, pg8::StaticOrder, true, true>(lds, g, S, E);
        }
        END_PHASE;
        if (RUN_PHASE) { PHASE_IDS
            for (int m = gw; m < MR; m += NGW) row_final(Y + (size_t)m * D, p.in[I_GMPOST], outr + (size_t)m * D, lane);
            if (rnd + 1 < NROUND) {
                const float* xn = p.in[I_XS] + (size_t)rnd * MR * D;
                for (int m = gw; m < MR; m += NGW) row_prenorm(xn + (size_t)m * D, p.in[I_GPRE], HB + (size_t)m * D, lane);
            }
        }
        END_PHASE;
    }
}

constexpr int NPHASES = 1 + NROUND * 9;

extern "C" void kernel_launch(void* const* d_in, const int* in_sizes, int n_in, void* d_out, int out_size, void* d_ws, size_t ws_size, hipStream_t stream) {
    static int grid = 0;
    if (grid == 0) {
        if (n_in != 21 || ws_size < WS_END) { fprintf(stderr, "kernel_launch: unexpected n_in %d / ws %zu\n", n_in, ws_size); grid = -1; return; }
        int dev = 0, cus = 0, per_cu = 0;
        hipGetDevice(&dev);
        hipDeviceGetAttribute(&cus, hipDeviceAttributeMultiprocessorCount, dev);
        hipFuncSetAttribute((const void*)fwd_kernel, hipFuncAttributeMaxDynamicSharedMemorySize, LDS_BYTES);
        hipOccupancyMaxActiveBlocksPerMultiprocessor(&per_cu, (const void*)fwd_kernel, 512, LDS_BYTES);
        if (per_cu < 1) { fprintf(stderr, "kernel_launch: occupancy query says %d blocks/CU\n", per_cu); per_cu = 1; }
        (void)hipGetLastError();
        grid = cus;
    }
    if (grid < 0) return;
    Params p{};
    for (int i = 0; i < 21; ++i) p.in[i] = (const float*)d_in[i];
    p.out = (float*)d_out; p.ws = (unsigned char*)d_ws;
#if N_LAUNCH_MODE == 1
    p.ph_lo = 0; p.ph_hi = NPHASES;
    void* args[] = {&p};
    hipError_t e = hipLaunchCooperativeKernel((const void*)fwd_kernel, dim3(grid), dim3(512), args, LDS_BYTES, stream);
    if (e != hipSuccess) fprintf(stderr, "cooperative launch failed: %s (grid %d)\n", hipGetErrorString(e), grid);
#else
    for (int i = 0; i < NPHASES; ++i) { p.ph_lo = i; p.ph_hi = i + 1; hipLaunchKernelGGL(fwd_kernel, dim3(grid), dim3(512), LDS_BYTES, stream, p); }
#endif
}
```

```cpp
#include <hip/hip_runtime.h>
#include <hip/hip_cooperative_groups.h>
#include <cstdio>
#include <cstdint>
namespace cg = cooperative_groups;

#ifndef N_LAUNCH_MODE
#define N_LAUNCH_MODE 1
#endif

#define LAS __attribute__((address_space(3)))
typedef unsigned short bf16_t;
typedef short bf16x8 __attribute__((ext_vector_type(8)));
typedef float f32x4 __attribute__((ext_vector_type(4)));
typedef float f32x16 __attribute__((ext_vector_type(16)));
typedef unsigned u32x4 __attribute__((ext_vector_type(4)));
typedef unsigned u32x2 __attribute__((ext_vector_type(2)));
typedef float f32x2_t __attribute__((ext_vector_type(2)));
typedef __bf16 bf16x2_t __attribute__((ext_vector_type(2)));

constexpr int D = 1024, NPROJ = 10240, FF = 4096;
constexpr int MR = 16384;
constexpr int NROUND = 5;
constexpr float EPS = 1e-6f;
constexpr float LOG2E = 1.4426950408889634f;
constexpr float QSCALE = 0.125f * LOG2E;
constexpr int C_AQ = 0, C_AK = 1024, C_AV = 2048, C_GQ = 3072, C_GFF = 4096, C_GFB = 5120, C_GI = 6144, C_GOG = 7168, C_GA = 8192, C_GB = 9216;

constexpr size_t MiB = 1u << 20;
constexpr size_t WS_CTL = 0;
constexpr size_t WS_WIN = 1 * MiB, WS_WA = 21 * MiB, WS_WB = 23 * MiB, WS_WOUT = 25 * MiB, WS_WUP = 27 * MiB, WS_WDN = 35 * MiB;
constexpr size_t WS_HB = 44 * MiB, WS_PROJ = 76 * MiB, WS_U = WS_PROJ, WS_VT = 396 * MiB, WS_OA = 428 * MiB, WS_OB = 460 * MiB;
constexpr size_t WS_MERGED = 492 * MiB, WS_Y = 524 * MiB, WS_OPART = 556 * MiB, WS_STASH = 684 * MiB, WS_SB = 716 * MiB, WS_DEC = 844 * MiB, WS_END = 848 * MiB;

__device__ __forceinline__ float bf2f(unsigned u) { return __uint_as_float(u << 16); }
__device__ __forceinline__ unsigned cvtpk(float lo, float hi) { f32x2_t v = {lo, hi}; bf16x2_t b = __builtin_convertvector(v, bf16x2_t); return __builtin_bit_cast(unsigned, b); }
__device__ __forceinline__ bf16_t f2bf(float f) { return (bf16_t)(cvtpk(f, 0.f) & 0xffffu); }
__device__ __forceinline__ float fexp2(float x) { return __builtin_amdgcn_exp2f(x); }
__device__ __forceinline__ float flog2(float x) { return __builtin_amdgcn_logf(x); }
__device__ __forceinline__ float frcp(float x) { return __builtin_amdgcn_rcpf(x); }
__device__ __forceinline__ float sigmoidf_(float x) { return frcp(1.f + fexp2(-x * LOG2E)); }
__device__ __forceinline__ int crow(int r, int hi) { return (r & 3) + 8 * (r >> 2) + 4 * hi; }

namespace pg8 {
constexpr int BM = 256, BK = 64, HALF = 128, HTB = HALF * BK * 2, STAGE_BYTES = 8 * HTB, NXCD = 8, WGM = 8;
__host__ __device__ __forceinline__ int lds_byte(int r, int c) { const int st = (r >> 4) * 2 + (c >> 5), rr = r & 15, cc = c & 31, ob = rr * 64 + cc * 2; return st * 1024 + (ob ^ (((ob >> 9) & 1) << 5)); }
__host__ __device__ __forceinline__ void stage_rc(int b, int& R, int& C) { const int st = b / 1024, sb = b % 1024, swz = sb ^ (((sb >> 9) & 1) << 5); R = (st >> 1) * 16 + swz / 64; C = (st & 1) * 32 + (swz % 64) / 2; }
__host__ __device__ __forceinline__ int perm32(int rho) { const int n = rho >> 4, i = rho & 15; return 8 * (i >> 2) + 4 * n + (i & 3); }
struct Unit { int pm, pn; };
struct Gemm { const bf16_t* A; const bf16_t* Bt; int M, N, K; };
struct StaticOrder {
    int nM, nN, nwg, G, c;
    __host__ __device__ void init(int M, int N, int G_, int c_) { nM = M / BM; nN = N / BM; nwg = nM * nN; G = G_; c = c_; }
    __host__ __device__ bool next(int i, Unit& u) const {
        const long L = (long)i * G + c; if (L >= nwg) return false;
        int wgid = (int)L; { const int q = nwg / NXCD, r = nwg % NXCD, xcd = wgid % NXCD, off = wgid / NXCD; wgid = (xcd < r ? xcd * (q + 1) : r * (q + 1) + (xcd - r) * q) + off; }
        const int nig = WGM * nN, gid = wgid / nig, fm = gid * WGM, gsz = (nM - fm) < WGM ? (nM - fm) : WGM;
        u.pm = fm + ((wgid % nig) % gsz); u.pn = (wgid % nig) / gsz; return true;
    }
    __device__ __forceinline__ void a_ready(const Unit&) const {}
    __device__ __forceinline__ void done(const Unit&) const {}
};

template <int MODE> struct Epi {
    static constexpr bool PERM = true, AFTER_DRAIN = false;
    bf16_t* O; int ldc; const bf16_t* G; int ldg; int gcol0; bf16_t* VT; int T;
    __device__ __forceinline__ void operator()(const f32x4 (&acc)[2][2][4][2], const Unit& u, int wr, int wc, int fr, int fq) const {
        const int row0 = u.pm * BM + wr * 64 + fr; const int colt = u.pn * BM; const int col0 = colt + wc * 32 + 8 * fq;
        if (MODE == 1 && colt >= C_AV && colt < C_AV + 1024) {
            const int s = (u.pm * BM) / T, t0 = (u.pm * BM) % T;
            const int pf = (fr & 3) | ((fr & 4) << 1) | ((fr & 8) >> 1);
#pragma unroll
            for (int ai = 0; ai < 2; ++ai)
#pragma unroll
                for (int m = 0; m < 4; ++m) { const int tpos = t0 + ai * 128 + wr * 64 + m * 16 + pf;
#pragma unroll
                    for (int bj = 0; bj < 2; ++bj) { const int head = (colt - C_AV) / 128 + bj;
#pragma unroll
                        for (int n = 0; n < 2; ++n)
#pragma unroll
                            for (int j = 0; j < 4; ++j) { const int dv = wc * 32 + 8 * fq + 4 * n + j;
                                VT[((size_t)(s * 8 + head) * 128 + dv) * T + tpos] = f2bf(acc[ai][bj][m][n][j]); } } }
            return;
        }
#pragma unroll
        for (int ai = 0; ai < 2; ++ai)
#pragma unroll
            for (int m = 0; m < 4; ++m) { const size_t row = (size_t)(row0 + ai * HALF + m * 16); bf16_t* rowp = O + row * ldc + col0;
#pragma unroll
                for (int bj = 0; bj < 2; ++bj) { f32x4 v0 = acc[ai][bj][m][0], v1 = acc[ai][bj][m][1];
                    if (MODE == 2 || MODE == 3) {
                        const u32x4 gw = *(const u32x4*)(G + row * ldg + gcol0 + col0 + bj * HALF);
                        v0[0] *= sigmoidf_(bf2f(gw[0] & 0xffffu)); v0[1] *= sigmoidf_(bf2f(gw[0] >> 16)); v0[2] *= sigmoidf_(bf2f(gw[1] & 0xffffu)); v0[3] *= sigmoidf_(bf2f(gw[1] >> 16));
                        v1[0] *= sigmoidf_(bf2f(gw[2] & 0xffffu)); v1[1] *= sigmoidf_(bf2f(gw[2] >> 16)); v1[2] *= sigmoidf_(bf2f(gw[3] & 0xffffu)); v1[3] *= sigmoidf_(bf2f(gw[3] >> 16));
                    }
                    if (MODE == 3) {
                        const u32x4 ow = *(const u32x4*)(rowp + bj * HALF);
                        v0[0] += bf2f(ow[0] & 0xffffu); v0[1] += bf2f(ow[0] >> 16); v0[2] += bf2f(ow[1] & 0xffffu); v0[3] += bf2f(ow[1] >> 16);
                        v1[0] += bf2f(ow[2] & 0xffffu); v1[1] += bf2f(ow[2] >> 16); v1[2] += bf2f(ow[3] & 0xffffu); v1[3] += bf2f(ow[3] >> 16);
                    }
                    if (MODE == 4) {
#pragma unroll
                        for (int j = 0; j < 4; ++j) { float a = fmaxf(v0[j], 0.f), b = fmaxf(v1[j], 0.f); v0[j] = a * a; v1[j] = b * b; }
                    }
                    u32x4 w; w.x = cvtpk(v0[0], v0[1]); w.y = cvtpk(v0[2], v0[3]); w.z = cvtpk(v1[0], v1[1]); w.w = cvtpk(v1[2], v1[3]);
                    *(u32x4*)(rowp + bj * HALF) = w; } }
    }
};

template <class EpiT, class Sched, bool ALIGN_EPI = false, bool SP2 = false>
__device__ __forceinline__ void gemm_phase(LAS unsigned char* lds, const Gemm g, const Sched& S, const EpiT& E) {
    int tid_ = threadIdx.x; asm volatile("" : "+v"(tid_));
    const int tid = tid_, wid = __builtin_amdgcn_readfirstlane(tid >> 6), lane = tid & 63, wr = wid >> 2, wc = wid & 3, fr = lane & 15, fq = lane >> 4;
    const int K = g.K, nt = K / BK;
    unsigned voffA[2], voffB[2];
#pragma unroll
    for (int i = 0; i < 2; ++i) { int R, C; stage_rc(tid * 16 + i * 8192, R, C); const int Rb = EpiT::PERM ? ((R & ~31) + perm32(R & 31)) : R;
        voffA[i] = (unsigned)(R * K + C) * 2u; voffB[i] = (unsigned)(Rb * K + C) * 2u; }
    const size_t kstep = (size_t)(BK * 2);
    const size_t hstep = (size_t)HALF * K * 2;
    const size_t tstep = 2 * hstep;
    const unsigned ldsw = (unsigned)wid * 1024u;
    const int aoff = lds_byte(wr * 64 + fr, fq * 8), boff = lds_byte(wc * 32 + fr, fq * 8);
#define PG8_SA(b, h) (((b) * 2 + (h)) * HTB)
#define PG8_SB(b, h) ((4 + (b) * 2 + (h)) * HTB)
#define PG8_STAGE(bufoff, gbase, voff) do { _Pragma("unroll") for (int _i = 0; _i < 2; ++_i) \
        __builtin_amdgcn_global_load_lds((const unsigned*)((const char*)(gbase) + (voff)[_i]), (LAS unsigned*)(lds + (bufoff) + ldsw + _i * 8192), 16, 0, 0); } while (0)
#define PG8_LDA(dst, b, h) do { _Pragma("unroll") for (int m = 0; m < 4; ++m) _Pragma("unroll") for (int k = 0; k < 2; ++k) dst[m][k] = *(const LAS bf16x8*)(lds + PG8_SA(b, h) + aoff + m * 2048 + k * 1024); } while (0)
#define PG8_LDB(dst, b, h) do { _Pragma("unroll") for (int n = 0; n < 2; ++n) _Pragma("unroll") for (int k = 0; k < 2; ++k) dst[n][k] = *(const LAS bf16x8*)(lds + PG8_SB(b, h) + boff + n * 2048 + k * 1024); } while (0)
#define PG8_MMA(ai, bj, At, Bt) do { __builtin_amdgcn_s_setprio(1); _Pragma("unroll") for (int m = 0; m < 4; ++m) _Pragma("unroll") for (int n = 0; n < 2; ++n) _Pragma("unroll") for (int k = 0; k < 2; ++k) \
        acc[ai][bj][m][n] = __builtin_amdgcn_mfma_f32_16x16x32_bf16(Bt[n][k], At[m][k], acc[ai][bj][m][n], 0, 0, 0); __builtin_amdgcn_s_setprio(0); } while (0)
#define PG8_WAIT_V(n) asm volatile("s_waitcnt vmcnt(" #n ")" ::: "memory")
#define PG8_WAIT_L(n) asm volatile("s_waitcnt lgkmcnt(" #n ")" ::: "memory")
#define PG8_BAR __builtin_amdgcn_s_barrier()
#define PG8_SCHED __builtin_amdgcn_sched_barrier(0)
    Unit cur, nxt; int ui = 0;
    if (!S.next(0, cur)) return;
    f32x4 acc[2][2][4][2];
#pragma unroll
    for (int a = 0; a < 2; ++a)
#pragma unroll
        for (int b = 0; b < 2; ++b)
#pragma unroll
            for (int m = 0; m < 4; ++m)
#pragma unroll
                for (int n = 0; n < 2; ++n) acc[a][b][m][n] = (f32x4){0.f, 0.f, 0.f, 0.f};
    bf16x8 At[4][2], B0[2][2], B1[2][2];
    const char* cA = (const char*)g.A + (size_t)cur.pm * tstep; const char* cB = (const char*)g.Bt + (size_t)cur.pn * tstep;
    S.a_ready(cur);
    if constexpr (SP2) {
        PG8_STAGE(PG8_SB(0, 0), cB, voffB); PG8_STAGE(PG8_SB(0, 1), cB + hstep, voffB); PG8_STAGE(PG8_SA(0, 0), cA, voffA); PG8_STAGE(PG8_SA(0, 1), cA + hstep, voffA);
        if (wr == 1) PG8_BAR;
        PG8_WAIT_V(2); PG8_BAR;
        PG8_STAGE(PG8_SB(1, 0), cB + kstep, voffB); PG8_STAGE(PG8_SA(1, 0), cA + kstep, voffA); PG8_STAGE(PG8_SB(1, 1), cB + hstep + kstep, voffB);
        PG8_WAIT_V(6); PG8_BAR;
    } else {
        PG8_STAGE(PG8_SB(0, 0), cB, voffB); PG8_STAGE(PG8_SA(0, 0), cA, voffA); PG8_STAGE(PG8_SB(0, 1), cB + hstep, voffB); PG8_STAGE(PG8_SA(0, 1), cA + hstep, voffA);
        if (wr == 1) PG8_BAR;
        PG8_WAIT_V(4); PG8_BAR;
        PG8_STAGE(PG8_SB(1, 0), cB + kstep, voffB); PG8_STAGE(PG8_SA(1, 0), cA + kstep, voffA); PG8_STAGE(PG8_SB(1, 1), cB + hstep + kstep, voffB);
        PG8_WAIT_V(6); PG8_BAR;
    }
    for (;;) {
        const bool has_next = S.next(ui + 1, nxt);
        const char* nA = has_next ? (const char*)g.A + (size_t)nxt.pm * tstep : cA; const char* nB = has_next ? (const char*)g.Bt + (size_t)nxt.pn * tstep : cB;
        for (int t = 0; t < nt; t += 2) {
            const bool last = (t == nt - 2);
            const char* a1 = cA + (size_t)(t + 1) * kstep;
            const char* a2 = last ? nA : cA + (size_t)(t + 2) * kstep; const char* b2 = last ? nB : cB + (size_t)(t + 2) * kstep;
            const char* a3 = a2 + kstep; const char* b3 = b2 + kstep;
            if (last && has_next) S.a_ready(nxt);
            if constexpr (SP2) {
            PG8_LDB(B0, 0, 0); PG8_LDB(B1, 0, 1); PG8_SCHED; PG8_LDA(At, 0, 0); PG8_STAGE(PG8_SA(1, 1), a1 + hstep, voffA);
            PG8_WAIT_V(8); PG8_WAIT_L(0); PG8_BAR; PG8_MMA(0, 0, At, B0); PG8_MMA(0, 1, At, B1); PG8_BAR; PG8_SCHED;
            PG8_LDA(At, 0, 1); PG8_STAGE(PG8_SB(0, 0), b2, voffB); PG8_STAGE(PG8_SB(0, 1), b2 + hstep, voffB); PG8_STAGE(PG8_SA(0, 0), a2, voffA);
            PG8_WAIT_V(8); PG8_WAIT_L(0); PG8_BAR; PG8_MMA(1, 0, At, B0); PG8_MMA(1, 1, At, B1); PG8_BAR; PG8_SCHED;
            PG8_LDB(B0, 1, 0); PG8_LDB(B1, 1, 1); PG8_SCHED; PG8_LDA(At, 1, 0); PG8_STAGE(PG8_SA(0, 1), a2 + hstep, voffA);
            PG8_WAIT_V(8); PG8_WAIT_L(0); PG8_BAR; PG8_MMA(0, 0, At, B0); PG8_MMA(0, 1, At, B1); PG8_BAR; PG8_SCHED;
            PG8_LDA(At, 1, 1); PG8_STAGE(PG8_SB(1, 0), b3, voffB); PG8_STAGE(PG8_SB(1, 1), b3 + hstep, voffB); PG8_STAGE(PG8_SA(1, 0), a3, voffA);
            PG8_WAIT_V(8); PG8_WAIT_L(0); PG8_BAR; PG8_MMA(1, 0, At, B0); PG8_MMA(1, 1, At, B1); PG8_BAR; PG8_SCHED;
            } else {
            PG8_LDB(B0, 0, 0); PG8_SCHED; PG8_LDA(At, 0, 0); PG8_STAGE(PG8_SA(1, 1), a1 + hstep, voffA);
            PG8_WAIT_L(8); PG8_BAR; PG8_WAIT_L(0); PG8_MMA(0, 0, At, B0); PG8_BAR; PG8_SCHED;
            PG8_LDB(B1, 0, 1); PG8_STAGE(PG8_SB(0, 0), b2, voffB);
            PG8_BAR; PG8_WAIT_L(0); PG8_MMA(0, 1, At, B1); PG8_BAR;
            PG8_LDA(At, 0, 1); PG8_STAGE(PG8_SA(0, 0), a2, voffA);
            PG8_BAR; PG8_WAIT_L(0); PG8_MMA(1, 0, At, B0); PG8_BAR; PG8_SCHED;
            PG8_STAGE(PG8_SB(0, 1), b2 + hstep, voffB);
            PG8_WAIT_V(6); PG8_BAR; PG8_MMA(1, 1, At, B1); PG8_BAR;
            PG8_LDB(B0, 1, 0); PG8_SCHED; PG8_LDA(At, 1, 0); PG8_STAGE(PG8_SA(0, 1), a2 + hstep, voffA);
            PG8_WAIT_L(8); PG8_BAR; PG8_WAIT_L(0); PG8_MMA(0, 0, At, B0); PG8_BAR; PG8_SCHED;
            PG8_LDB(B1, 1, 1); PG8_STAGE(PG8_SB(1, 0), b3, voffB);
            PG8_BAR; PG8_WAIT_L(0); PG8_MMA(0, 1, At, B1); PG8_BAR;
            PG8_LDA(At, 1, 1); PG8_STAGE(PG8_SA(1, 0), a3, voffA);
            PG8_BAR; PG8_WAIT_L(0); PG8_MMA(1, 0, At, B0); PG8_BAR; PG8_SCHED;
            PG8_STAGE(PG8_SB(1, 1), b3 + hstep, voffB);
            PG8_WAIT_V(6); PG8_BAR; PG8_MMA(1, 1, At, B1); PG8_BAR;
            }
        }
        if constexpr (ALIGN_EPI) { if (wr == 0) PG8_BAR; }
        if constexpr (!EpiT::AFTER_DRAIN) { E(acc, cur, wr, wc, fr, fq); S.done(cur); }
        if (!has_next) break;
#pragma unroll
        for (int a = 0; a < 2; ++a)
#pragma unroll
            for (int b = 0; b < 2; ++b)
#pragma unroll
                for (int m = 0; m < 4; ++m)
#pragma unroll
                    for (int n = 0; n < 2; ++n) acc[a][b][m][n] = (f32x4){0.f, 0.f, 0.f, 0.f};
        cur = nxt; cA = nA; cB = nB; ++ui;
        if constexpr (ALIGN_EPI) { if (wr == 1) PG8_BAR; }
    }
    PG8_WAIT_V(0);
    if constexpr (!ALIGN_EPI) { if (wr == 0) PG8_BAR; }
    PG8_BAR;
#undef PG8_SA
#undef PG8_SB
#undef PG8_STAGE
#undef PG8_LDA
#undef PG8_LDB
#undef PG8_MMA
#undef PG8_WAIT_V
#undef PG8_WAIT_L
#undef PG8_BAR
#undef PG8_SCHED
}
}

struct Params {
    const float* in[21];
    float* out;
    unsigned char* ws;
    int ph_lo, ph_hi;
};
enum { I_XP = 0, I_XS, I_RELB, I_GPRE, I_WIN, I_LQ1, I_LK1, I_LQ2, I_LK2, I_GSUB, I_LBF, I_LBB, I_GHO, I_WPA, I_WPB, I_WOUT, I_GPOST, I_GMPRE, I_WUP, I_WDN, I_GMPOST };

constexpr int LDS_BYTES = 151552;

__device__ __forceinline__ float wave_sum(float v) {
#pragma unroll
    for (int o = 1; o < 64; o <<= 1) v += __shfl_xor(v, o);
    return v;
}
__device__ __forceinline__ float half_sum(float v) {
#pragma unroll
    for (int o = 1; o < 32; o <<= 1) v += __shfl_xor(v, o);
    return v;
}

__device__ __forceinline__ void p0_transpose_item(const float* W, int K, int N, bf16_t* WT, LAS float* scr, int item, int lane, bool scale_q) {
    const int nblk = N / 32, kb = item / nblk, nb = item % nblk, k0 = 64 * kb, n0 = 32 * nb;
    const float sc = (scale_q && n0 < 1024) ? QSCALE : 1.f;
#pragma unroll 8
    for (int i = 0; i < 32; ++i) { const int kk = 2 * i + (lane >> 5); scr[kk * 33 + (lane & 31)] = W[(size_t)(k0 + kk) * N + n0 + (lane & 31)] * sc; }
    asm volatile("s_waitcnt lgkmcnt(0)" ::: "memory");
    const int c = lane & 7;
#pragma unroll
    for (int j = 0; j < 4; ++j) { const int n = (lane >> 3) + 8 * j; const LAS float* s = scr + (8 * c) * 33 + n;
        u32x4 o; o.x = cvtpk(s[0 * 33], s[1 * 33]); o.y = cvtpk(s[2 * 33], s[3 * 33]); o.z = cvtpk(s[4 * 33], s[5 * 33]); o.w = cvtpk(s[6 * 33], s[7 * 33]);
        *(u32x4*)(WT + (size_t)(n0 + n) * K + k0 + 8 * c) = o; }
    asm volatile("s_waitcnt lgkmcnt(0)" ::: "memory");
}

__device__ __forceinline__ void row_prenorm(const float* xrow, const float* g, bf16_t* orow, int lane) {
    f32x4 v[4]; float s = 0.f;
#pragma unroll
    for (int j = 0; j < 4; ++j) { v[j] = *(const f32x4*)(xrow + 4 * lane + 256 * j); s += (v[j].x * v[j].x + v[j].y * v[j].y) + (v[j].z * v[j].z + v[j].w * v[j].w); }
    const float r = 1.f / sqrtf(wave_sum(s) * (1.f / D) + EPS);
#pragma unroll
    for (int j = 0; j < 4; ++j) { const f32x4 gg = *(const f32x4*)(g + 4 * lane + 256 * j);
        u32x2 w; w.x = cvtpk(v[j].x * r * gg.x, v[j].y * r * gg.y); w.y = cvtpk(v[j].z * r * gg.z, v[j].w * r * gg.w);
        *(u32x2*)(orow + 4 * lane + 256 * j) = w; }
}
__device__ __forceinline__ void row_normres1(const float* xrow, const bf16_t* yrow, const float* g1, const float* g2, float* outrow, bf16_t* hrow, int lane) {
    f32x4 y[4]; float s = 0.f;
#pragma unroll
    for (int j = 0; j < 4; ++j) { const u32x2 w = *(const u32x2*)(yrow + 4 * lane + 256 * j);
        y[j] = (f32x4){bf2f(w.x & 0xffffu), bf2f(w.x >> 16), bf2f(w.y & 0xffffu), bf2f(w.y >> 16)};
        s += (y[j].x * y[j].x + y[j].y * y[j].y) + (y[j].z * y[j].z + y[j].w * y[j].w); }
    const float r = 1.f / sqrtf(wave_sum(s) * (1.f / D) + EPS);
    float s2 = 0.f;
#pragma unroll
    for (int j = 0; j < 4; ++j) { const f32x4 xx = *(const f32x4*)(xrow + 4 * lane + 256 * j); const f32x4 gg = *(const f32x4*)(g1 + 4 * lane + 256 * j);
        y[j] = xx + y[j] * r * gg; *(f32x4*)(outrow + 4 * lane + 256 * j) = y[j];
        s2 += (y[j].x * y[j].x + y[j].y * y[j].y) + (y[j].z * y[j].z + y[j].w * y[j].w); }
    const float r2 = 1.f / sqrtf(wave_sum(s2) * (1.f / D) + EPS);
#pragma unroll
    for (int j = 0; j < 4; ++j) { const f32x4 gg = *(const f32x4*)(g2 + 4 * lane + 256 * j);
        u32x2 w; w.x = cvtpk(y[j].x * r2 * gg.x, y[j].y * r2 * gg.y); w.y = cvtpk(y[j].z * r2 * gg.z, y[j].w * r2 * gg.w);
        *(u32x2*)(hrow + 4 * lane + 256 * j) = w; }
}
__device__ __forceinline__ void row_final(const bf16_t* yrow, const float* g, float* outrow, int lane) {
    f32x4 y[4]; float s = 0.f;
#pragma unroll
    for (int j = 0; j < 4; ++j) { const u32x2 w = *(const u32x2*)(yrow + 4 * lane + 256 * j);
        y[j] = (f32x4){bf2f(w.x & 0xffffu), bf2f(w.x >> 16), bf2f(w.y & 0xffffu), bf2f(w.y >> 16)};
        s += (y[j].x * y[j].x + y[j].y * y[j].y) + (y[j].z * y[j].z + y[j].w * y[j].w); }
    const float r = 1.f / sqrtf(wave_sum(s) * (1.f / D) + EPS);
#pragma unroll
    for (int j = 0; j < 4; ++j) { const f32x4 xx = *(const f32x4*)(outrow + 4 * lane + 256 * j); const f32x4 gg = *(const f32x4*)(g + 4 * lane + 256 * j);
        *(f32x4*)(outrow + 4 * lane + 256 * j) = xx + y[j] * r * gg; }
}
__device__ __forceinline__ void row_hgrn_fin(const float* of, const float* ob, const bf16_t* ogrow, const float* gout, bf16_t* orow, int lane) {
#pragma unroll
    for (int j = 0; j < 4; ++j) {
        const int col = 4 * lane + 256 * j;
        f32x4 v = *(const f32x4*)(of + col) + *(const f32x4*)(ob + col);
        const float ss = half_sum((v.x * v.x + v.y * v.y) + (v.z * v.z + v.w * v.w));
        const float r = 1.f / sqrtf(ss * (1.f / 128.f) + EPS);
        const f32x4 gg = *(const f32x4*)(gout + (col & 127));
        const u32x2 w = *(const u32x2*)(ogrow + col);
        const float g0 = bf2f(w.x & 0xffffu), g1 = bf2f(w.x >> 16), g2 = bf2f(w.y & 0xffffu), g3 = bf2f(w.y >> 16);
        u32x2 o; o.x = cvtpk(v.x * r * gg.x * g0 * sigmoidf_(g0), v.y * r * gg.y * g1 * sigmoidf_(g1));
        o.y = cvtpk(v.z * r * gg.z * g2 * sigmoidf_(g2), v.w * r * gg.w * g3 * sigmoidf_(g3));
        *(u32x2*)(orow + col) = o;
    }
}

constexpr int AT_K0 = 0, AT_V0 = 16384, AT_TAB = 49152;
__device__ __forceinline__ int t5_bucket_dev(int rel) {
    const int n = rel < 0 ? -rel : rel; const int ret = rel > 0 ? 16 : 0;
    int b;
    if (n < 8) b = n; else if (n < 12) b = 8; else if (n < 16) b = 9; else if (n < 23) b = 10; else if (n < 32) b = 11; else if (n < 46) b = 12; else if (n < 64) b = 13; else if (n < 91) b = 14; else b = 15;
    return ret + b;
}
__device__ __forceinline__ void attn_item(LAS unsigned char* lds, const bf16_t* proj, const bf16_t* vT, bf16_t* oa, float* stash, const float* relb, const float* gsub, float lam,
                                          int s, int h, int qb, int T) {
    int tid_ = threadIdx.x; asm volatile("" : "+v"(tid_));
    const int tid = tid_, lane = tid & 63, r32 = lane & 31, hi = lane >> 5; const int wid = __builtin_amdgcn_readfirstlane(tid >> 6);
    const int NT = T / 64;
    const size_t rowbase = (size_t)s * T;
    LAS float* tab = (LAS float*)(lds + AT_TAB);
    __syncthreads();
    for (int i = tid; i < 257; i += 512) tab[i] = relb[t5_bucket_dev(i - 128) * 8 + h] * LOG2E;
    const float cL = relb[15 * 8 + h] * LOG2E, cR = relb[31 * 8 + h] * LOG2E;
    const int qlo = qb * 256 + wid * 32;
    const size_t qrow = rowbase + qlo + r32;
    const int kkey = tid >> 3, kch = tid & 7;
    const unsigned kdst = (kch >> 1) * 2048 + (kch & 1) * 1024 + (kkey >> 5) * 512 + (kkey & 31) * 16;
    unsigned vdst[2]; const bf16_t* vsrc[2];
#pragma unroll
    for (int i = 0; i < 2; ++i) { const int idx = tid + 512 * i, dv = idx >> 3, ch = idx & 7;
        vdst[i] = ((dv >> 5) * 4 + (ch >> 1)) * 1024 + (ch & 1) * 512 + (dv & 31) * 16;
        vsrc[i] = vT + ((size_t)(s * 8 + h) * 128 + dv) * T + ch * 8; }
    float* st = stash + ((size_t)blockIdx.x * 512 + tid) * 64;
#pragma unroll 1
    for (int c = 0; c < 2; ++c) {
        bf16x8 qr[4];
#pragma unroll
        for (int d0 = 0; d0 < 4; ++d0) qr[d0] = *(const bf16x8*)(proj + qrow * NPROJ + C_AQ + h * 128 + c * 64 + 16 * d0 + 8 * hi);
        const bf16_t* ksrc = proj + (rowbase + kkey) * NPROJ + C_AK + h * 128 + c * 64 + kch * 8;
        f32x16 o[4];
#pragma unroll
        for (int i = 0; i < 4; ++i)
#pragma unroll
            for (int r = 0; r < 16; ++r) o[i][r] = 0.f;
        float l = 0.f;
        __syncthreads();
        {
            const u32x4 kreg = *(const u32x4*)(ksrc);
            const u32x4 v0 = *(const u32x4*)(vsrc[0]), v1 = *(const u32x4*)(vsrc[1]);
            *(LAS u32x4*)(lds + AT_K0 + kdst) = kreg; *(LAS u32x4*)(lds + AT_V0 + vdst[0]) = v0; *(LAS u32x4*)(lds + AT_V0 + vdst[1]) = v1;
        }
        __syncthreads();
#pragma unroll 1
        for (int kt = 0; kt < NT; ++kt) {
            const int cur = kt & 1; const bool more = (kt + 1 < NT);
            u32x4 kreg, v0, v1;
            if (more) { kreg = *(const u32x4*)(ksrc + (size_t)(kt + 1) * 64 * NPROJ); v0 = *(const u32x4*)(vsrc[0] + (kt + 1) * 64); v1 = *(const u32x4*)(vsrc[1] + (kt + 1) * 64); }
            const LAS unsigned char* Kb = lds + AT_K0 + cur * 8192; const LAS unsigned char* Vb = lds + AT_V0 + cur * 16384;
            f32x16 p0, p1;
#pragma unroll
            for (int r = 0; r < 16; ++r) { p0[r] = 0.f; p1[r] = 0.f; }
#pragma unroll
            for (int d0 = 0; d0 < 4; ++d0) {
                const bf16x8 a0 = *(const LAS bf16x8*)(Kb + d0 * 2048 + hi * 1024 + r32 * 16);
                const bf16x8 a1 = *(const LAS bf16x8*)(Kb + d0 * 2048 + hi * 1024 + 512 + r32 * 16);
                p0 = __builtin_amdgcn_mfma_f32_32x32x16_bf16(a0, qr[d0], p0, 0, 0, 0);
                p1 = __builtin_amdgcn_mfma_f32_32x32x16_bf16(a1, qr[d0], p1, 0, 0, 0);
            }
            __builtin_amdgcn_sched_barrier(0);
            const int k0 = kt * 64;
            if (k0 - (qlo + 31) >= 128) {
#pragma unroll
                for (int r = 0; r < 16; ++r) { p0[r] = fexp2(p0[r] + cR); p1[r] = fexp2(p1[r] + cR); }
            } else if (k0 + 63 - qlo <= -128) {
#pragma unroll
                for (int r = 0; r < 16; ++r) { p0[r] = fexp2(p0[r] + cL); p1[r] = fexp2(p1[r] + cL); }
            } else {
                const int qpos = qlo + r32;
#pragma unroll
                for (int r = 0; r < 16; ++r) {
                    const int rel0 = k0 + crow(r, hi) - qpos, rel1 = rel0 + 32;
                    const int i0 = min(max(rel0, -128), 128) + 128, i1 = min(max(rel1, -128), 128) + 128;
                    p0[r] = fexp2(p0[r] + tab[i0]); p1[r] = fexp2(p1[r] + tab[i1]);
                }
            }
            float sa = 0.f, sb = 0.f;
#pragma unroll
            for (int r = 0; r < 16; ++r) { sa += p0[r]; sb += p1[r]; }
            l += sa + sb;
            u32x4 pw[4];
#pragma unroll
            for (int i = 0; i < 4; ++i) { pw[0][i] = cvtpk(p0[2 * i], p0[2 * i + 1]); pw[1][i] = cvtpk(p0[8 + 2 * i], p0[8 + 2 * i + 1]);
                                          pw[2][i] = cvtpk(p1[2 * i], p1[2 * i + 1]); pw[3][i] = cvtpk(p1[8 + 2 * i], p1[8 + 2 * i + 1]); }
            __builtin_amdgcn_sched_barrier(0);
#pragma unroll
            for (int ks = 0; ks < 4; ++ks) {
#pragma unroll
                for (int dvb = 0; dvb < 4; ++dvb) {
                    const bf16x8 vf = *(const LAS bf16x8*)(Vb + (dvb * 4 + ks) * 1024 + hi * 512 + r32 * 16);
                    o[dvb] = __builtin_amdgcn_mfma_f32_32x32x16_bf16(vf, __builtin_bit_cast(bf16x8, pw[ks]), o[dvb], 0, 0, 0);
                }
                __builtin_amdgcn_sched_barrier(0);
            }
            if (more) { const int nx = cur ^ 1;
                *(LAS u32x4*)(lds + AT_K0 + nx * 8192 + kdst) = kreg; *(LAS u32x4*)(lds + AT_V0 + nx * 16384 + vdst[0]) = v0; *(LAS u32x4*)(lds + AT_V0 + nx * 16384 + vdst[1]) = v1; }
            __syncthreads();
        }
        l += __shfl_xor(l, 32);
        const float rl = 1.f / l;
        if (c == 0) {
#pragma unroll
            for (int i = 0; i < 4; ++i)
#pragma unroll
                for (int g = 0; g < 4; ++g) *(f32x4*)(st + i * 16 + 4 * g) = (f32x4){o[i][4 * g] * rl, o[i][4 * g + 1] * rl, o[i][4 * g + 2] * rl, o[i][4 * g + 3] * rl};
        } else {
            float ss = 0.f;
#pragma unroll
            for (int i = 0; i < 4; ++i)
#pragma unroll
                for (int g = 0; g < 4; ++g) { const f32x4 s0 = *(const f32x4*)(st + i * 16 + 4 * g);
#pragma unroll
                    for (int j = 0; j < 4; ++j) { const float v = s0[j] - lam * (o[i][4 * g + j] * rl); o[i][4 * g + j] = v; ss += v * v; } }
            ss += __shfl_xor(ss, 32);
            const float rn = 0.8f / sqrtf(ss * (1.f / 128.f) + EPS);
            bf16_t* orow = oa + qrow * D + h * 128;
#pragma unroll
            for (int i = 0; i < 4; ++i)
#pragma unroll
                for (int g = 0; g < 4; ++g) { const int dv = 32 * i + 8 * g + 4 * hi; const f32x4 gg = *(const f32x4*)(gsub + dv);
                    u32x2 w; w.x = cvtpk(o[i][4 * g] * rn * gg.x, o[i][4 * g + 1] * rn * gg.y); w.y = cvtpk(o[i][4 * g + 2] * rn * gg.z, o[i][4 * g + 3] * rn * gg.w);
                    *(u32x2*)(orow + dv) = w; }
        }
    }
}

constexpr int HG_QT = 0, HG_KT = 17408, HG_QH = 34816, HG_VT = 52224, HG_DIR = 70656;
constexpr int HG_HS = 2 * HG_DIR;
static_assert(HG_HS + 2048 <= LDS_BYTES, "HGRN LDS map");
struct HgIds { int tid, lane, r32, hi, wid, d, k, half, wq; };
__device__ __forceinline__ HgIds hg_ids() {
    int tid_ = threadIdx.x; asm volatile("" : "+v"(tid_));
    HgIds I; I.tid = tid_; I.lane = tid_ & 63; I.r32 = I.lane & 31; I.hi = I.lane >> 5; I.wid = __builtin_amdgcn_readfirstlane(tid_ >> 6);
    I.d = tid_ >> 8; I.k = tid_ & 127; I.half = (tid_ >> 7) & 1; I.wq = I.wid & 3; return I;
}
__device__ __forceinline__ void hgrn_a_item(LAS unsigned char* lds, const bf16_t* proj, bf16_t* SB, float* DEC, const float* lbfw, const float* lbbw, int s, int h, int c, int T) {
    const HgIds I = hg_ids(); const int d = I.d, k = I.k, half = I.half, r32 = I.r32, hi = I.hi;
    LAS unsigned char* L = lds + d * HG_DIR; LAS float* hs = (LAS float*)(lds + HG_HS);
    const float* lbw = d ? lbbw : lbfw;
    const float lb = sigmoidf_(lbw[h * 128 + k] - lbw[1024 + h * 128 + k]), omlb = 1.f - lb;
    const size_t rowbase = (size_t)s * T; const int NC = T / 64;
    const int zcol = (d ? C_GFB : C_GFF) + h * 128 + k, vcol = C_GI + h * 128 + k;
    float g2[32], kk[32]; float run = 0.f;
    {
        unsigned zr[32], vr[32];
#pragma unroll
        for (int ii = 0; ii < 32; ++ii) { const int i = 32 * half + ii; const int tk = d ? (T - 1 - (64 * c + i)) : (64 * c + i); const bf16_t* rp = proj + (rowbase + tk) * NPROJ;
            zr[ii] = rp[zcol]; vr[ii] = rp[vcol]; }
#pragma unroll
        for (int q4 = 0; q4 < 4; ++q4) { u32x4 w;
#pragma unroll
            for (int e = 0; e < 4; ++e) w[e] = vr[8 * q4 + 2 * e] | (vr[8 * q4 + 2 * e + 1] << 16);
            *(LAS u32x4*)(L + HG_VT + k * 144 + (32 * half + 8 * q4) * 2) = w; }
#pragma unroll
        for (int ii = 0; ii < 32; ++ii) { const float sg = sigmoidf_(bf2f(zr[ii])); const float f = lb + omlb * sg;
            kk[ii] = omlb * (1.f - sg); run += flog2(f); g2[ii] = run; }
    }
    hs[(d * 2 + half) * 128 + k] = run;
    __syncthreads();
    const float h0 = hs[(d * 2 + 0) * 128 + k], blast = h0 + hs[(d * 2 + 1) * 128 + k];
    const float boff = half ? h0 : 0.f;
    const size_t slot = ((size_t)((s * 8 + h) * 2 + d)) * NC + c;
    if (half == 0) DEC[slot * 128 + k] = fexp2(blast);
    {
        unsigned ktt[32];
#pragma unroll
        for (int ii = 0; ii < 32; ++ii) ktt[ii] = f2bf(kk[ii] * fexp2(blast - (g2[ii] + boff)));
#pragma unroll
        for (int q4 = 0; q4 < 4; ++q4) { u32x4 w;
#pragma unroll
            for (int e = 0; e < 4; ++e) w[e] = ktt[8 * q4 + 2 * e] | (ktt[8 * q4 + 2 * e + 1] << 16);
            *(LAS u32x4*)(L + HG_QT + k * 144 + (32 * half + 8 * q4) * 2) = w; }
    }
    __syncthreads();
    f32x16 acc[4];
#pragma unroll
    for (int i = 0; i < 4; ++i)
#pragma unroll
        for (int r = 0; r < 16; ++r) acc[i][r] = 0.f;
#pragma unroll
    for (int ks = 0; ks < 4; ++ks) {
        const bf16x8 vf = *(const LAS bf16x8*)(L + HG_VT + (32 * I.wq + r32) * 144 + (16 * ks + 8 * hi) * 2);
#pragma unroll
        for (int kb = 0; kb < 4; ++kb) {
            const bf16x8 kf = *(const LAS bf16x8*)(L + HG_QT + (32 * kb + r32) * 144 + (16 * ks + 8 * hi) * 2);
            acc[kb] = __builtin_amdgcn_mfma_f32_32x32x16_bf16(vf, kf, acc[kb], 0, 0, 0);
        }
    }
    bf16_t* sp = SB + slot * 16384;
#pragma unroll
    for (int kb = 0; kb < 4; ++kb)
#pragma unroll
        for (int r = 0; r < 16; ++r) sp[(32 * I.wq + crow(r, hi)) * 128 + 32 * kb + r32] = f2bf(acc[kb][r]);
    __syncthreads();
}
__device__ __forceinline__ void hgrn_scan_item(bf16_t* SB, const float* DEC, int chain, int part, int NC) {
    int tid_ = threadIdx.x; asm volatile("" : "+v"(tid_));
    const int e = part * 512 + tid_, dv = e >> 4, k8 = (e & 15) * 8;
    bf16_t* sp = SB + (size_t)chain * NC * 16384 + dv * 128 + k8; const float* dp = DEC + (size_t)chain * NC * 128 + k8;
    float st[8];
#pragma unroll
    for (int j = 0; j < 8; ++j) st[j] = 0.f;
#pragma unroll 4
    for (int c = 0; c < NC; ++c) {
        const u32x4 w = *(const u32x4*)(sp + (size_t)c * 16384);
        const f32x4 d0 = *(const f32x4*)(dp + (size_t)c * 128), d1 = *(const f32x4*)(dp + (size_t)c * 128 + 4);
        u32x4 o; o.x = cvtpk(st[0], st[1]); o.y = cvtpk(st[2], st[3]); o.z = cvtpk(st[4], st[5]); o.w = cvtpk(st[6], st[7]);
        *(u32x4*)(sp + (size_t)c * 16384) = o;
        st[0] = d0.x * st[0] + bf2f(w.x & 0xffffu); st[1] = d0.y * st[1] + bf2f(w.x >> 16); st[2] = d0.z * st[2] + bf2f(w.y & 0xffffu); st[3] = d0.w * st[3] + bf2f(w.y >> 16);
        st[4] = d1.x * st[4] + bf2f(w.z & 0xffffu); st[5] = d1.y * st[5] + bf2f(w.z >> 16); st[6] = d1.z * st[6] + bf2f(w.w & 0xffffu); st[7] = d1.w * st[7] + bf2f(w.w >> 16);
    }
}
__device__ __forceinline__ void hgrn_c_item(LAS unsigned char* lds, const bf16_t* proj, const bf16_t* SB, float* opart, const float* lbfw, const float* lbbw, int s, int h, int c, int T) {
    const HgIds I = hg_ids(); const int d = I.d, k = I.k, half = I.half, r32 = I.r32, hi = I.hi, dvb = I.wq;
    LAS unsigned char* L = lds + d * HG_DIR; LAS float* hs = (LAS float*)(lds + HG_HS);
    const float* lbw = d ? lbbw : lbfw;
    const float lb = sigmoidf_(lbw[h * 128 + k] - lbw[1024 + h * 128 + k]), omlb = 1.f - lb;
    const size_t rowbase = (size_t)s * T; const int NC = T / 64;
    const int zcol = (d ? C_GFB : C_GFF) + h * 128 + k, qcol = C_GQ + h * 128 + k, vcol = C_GI + h * 128 + k;
    const size_t slot = ((size_t)((s * 8 + h) * 2 + d)) * NC + c;
    bf16x8 sf[8];
    { const bf16_t* sp = SB + slot * 16384 + (32 * dvb + r32) * 128 + 8 * hi;
#pragma unroll
      for (int ks = 0; ks < 8; ++ks) sf[ks] = *(const bf16x8*)(sp + 16 * ks); }
    float g2[32], kk[32]; unsigned qv[32]; float run = 0.f;
    {
        unsigned zr[32], vr[32];
#pragma unroll
        for (int ii = 0; ii < 32; ++ii) { const int i = 32 * half + ii; const int tk = d ? (T - 1 - (64 * c + i)) : (64 * c + i); const bf16_t* rp = proj + (rowbase + tk) * NPROJ;
            zr[ii] = rp[zcol]; qv[ii] = rp[qcol]; vr[ii] = rp[vcol]; }
#pragma unroll
        for (int q4 = 0; q4 < 4; ++q4) { u32x4 w;
#pragma unroll
            for (int e = 0; e < 4; ++e) w[e] = vr[8 * q4 + 2 * e] | (vr[8 * q4 + 2 * e + 1] << 16);
            *(LAS u32x4*)(L + HG_VT + k * 144 + (32 * half + 8 * q4) * 2) = w; }
#pragma unroll
        for (int ii = 0; ii < 32; ++ii) { const float sg = sigmoidf_(bf2f(zr[ii])); const float f = lb + omlb * sg;
            kk[ii] = omlb * (1.f - sg); run += flog2(f); g2[ii] = run; }
    }
    hs[(d * 2 + half) * 128 + k] = run;
    __syncthreads();
    const float cref = hs[(d * 2 + 0) * 128 + k];
    const float boff = half ? cref : 0.f;
#pragma unroll
    for (int ii = 0; ii < 32; ++ii) { const int i = 32 * half + ii; const float b = g2[ii] + boff, bb = b - cref;
        const float e1 = fexp2(fminf(bb, 100.f)), e2 = fexp2(fminf(-bb, 100.f)); const float qf = bf2f(qv[ii]);
        *(LAS bf16_t*)(L + HG_QT + i * 272 + k * 2) = f2bf(qf * e1); *(LAS bf16_t*)(L + HG_KT + i * 272 + k * 2) = f2bf(kk[ii] * e2);
        *(LAS bf16_t*)(L + HG_QH + i * 272 + k * 2) = f2bf(qf * fexp2(b)); }
    __syncthreads();
    f32x16 am;
#pragma unroll
    for (int r = 0; r < 16; ++r) am[r] = 0.f;
    const int tb = (dvb == 0 || dvb == 3) ? 0 : 1, sb = (dvb >= 2) ? 1 : 0;
    if (dvb < 3) {
#pragma unroll
        for (int ks = 0; ks < 8; ++ks) {
            const bf16x8 a = *(const LAS bf16x8*)(L + HG_QT + (32 * tb + r32) * 272 + (16 * ks + 8 * hi) * 2);
            const bf16x8 b = *(const LAS bf16x8*)(L + HG_KT + (32 * sb + r32) * 272 + (16 * ks + 8 * hi) * 2);
            am = __builtin_amdgcn_mfma_f32_32x32x16_bf16(a, b, am, 0, 0, 0);
        }
    }
    f32x16 o[2];
#pragma unroll
    for (int i = 0; i < 2; ++i)
#pragma unroll
        for (int r = 0; r < 16; ++r) o[i][r] = 0.f;
#pragma unroll
    for (int ks = 0; ks < 8; ++ks)
#pragma unroll
        for (int tb2 = 0; tb2 < 2; ++tb2) {
            const bf16x8 af = *(const LAS bf16x8*)(L + HG_QH + (32 * tb2 + r32) * 272 + (16 * ks + 8 * hi) * 2);
            o[tb2] = __builtin_amdgcn_mfma_f32_32x32x16_bf16(af, sf[ks], o[tb2], 0, 0, 0);
        }
    __syncthreads();
#pragma unroll
    for (int r = 0; r < 16; ++r) { const int t = 32 * tb + crow(r, hi), sc = 32 * sb + r32; const float v = (sc <= t) ? am[r] : 0.f;
        *(LAS bf16_t*)(L + HG_KT + t * 272 + sc * 2) = f2bf(v); }
    __syncthreads();
#pragma unroll
    for (int ks = 0; ks < 4; ++ks) {
        const bf16x8 vf = *(const LAS bf16x8*)(L + HG_VT + (32 * dvb + r32) * 144 + (16 * ks + 8 * hi) * 2);
#pragma unroll
        for (int tb2 = 0; tb2 < 2; ++tb2) {
            const bf16x8 af = *(const LAS bf16x8*)(L + HG_KT + (32 * tb2 + r32) * 272 + (16 * ks + 8 * hi) * 2);
            o[tb2] = __builtin_amdgcn_mfma_f32_32x32x16_bf16(af, vf, o[tb2], 0, 0, 0);
        }
    }
    float* op = opart + (size_t)d * MR * D;
#pragma unroll
    for (int tb2 = 0; tb2 < 2; ++tb2)
#pragma unroll
        for (int r = 0; r < 16; ++r) { const int i = 32 * tb2 + crow(r, hi); const int tk = d ? (T - 1 - (64 * c + i)) : (64 * c + i);
            op[(rowbase + tk) * D + h * 128 + 32 * dvb + r32] = o[tb2][r]; }
    __syncthreads();
}

#define RLX_AGENT __ATOMIC_RELAXED, __HIP_MEMORY_SCOPE_AGENT
#define XB_TMO      128
#define XB_XCNT(j)  (256  + 64 * (j))
#define XB_XSUB(j)  (1280 + 64 * (j))
#define XB_XGEN(j)  (2304 + 64 * (j))
#define XB_TOP      3328
#define XB_TOPGEN   3392
#define XCD_BAR_WORDS 3456
#define XB_SPIN_CAP (1u << 18)

__device__ __forceinline__ unsigned xb_ld(unsigned* p)              { return __hip_atomic_load(p, __ATOMIC_RELAXED, __HIP_MEMORY_SCOPE_AGENT); }
__device__ __forceinline__ unsigned xb_add(unsigned* p, unsigned v) { return __hip_atomic_fetch_add(p, v, __ATOMIC_RELAXED, __HIP_MEMORY_SCOPE_AGENT); }
__device__ __forceinline__ unsigned xb_xcc_id() { return (unsigned)__builtin_amdgcn_s_getreg((3 << 11) | 20) & 0xFu; }
#define XB_SPIN(cond, bar) do { unsigned _sp = 0; while (cond) { __builtin_amdgcn_s_sleep(1); \
    if ((++_sp & 255u) == 0u) { if (xb_ld(&(bar)[XB_TMO])) break; if (_sp > XB_SPIN_CAP) { atomicAdd(&(bar)[XB_TMO], 1u); break; } } } } while (0)

struct XcdBarrier {
    unsigned* bar; unsigned x;
    volatile LAS unsigned* st;
};

__device__ __forceinline__ XcdBarrier xcd_barrier_post(unsigned* bar, volatile LAS unsigned* st) {
    XcdBarrier b; b.bar = bar; b.x = xb_xcc_id(); b.st = st;
    if (threadIdx.x == 0) (void)xb_add(&bar[XB_XCNT(b.x)], 1u);
    return b;
}
__device__ __forceinline__ void xcd_barrier_complete(unsigned* bar, unsigned x, unsigned& nloc, unsigned& nx) {
    const unsigned G = gridDim.x * gridDim.y * gridDim.z;
    unsigned sum, cnt, mine, sp = 0u;
    for (;;) {
        sum = 0u; cnt = 0u; mine = 0u;
#pragma unroll
        for (unsigned j = 0; j < 16; ++j) { const unsigned c = xb_ld(&bar[XB_XCNT(j)]); sum += c; cnt += (c > 0u) ? 1u : 0u; mine = (j == x) ? c : mine; }
        if (sum == G) break;
        __builtin_amdgcn_s_sleep(1);
        if ((++sp & 255u) == 0u) { if (xb_ld(&bar[XB_TMO])) break; if (sp > XB_SPIN_CAP) { atomicAdd(&bar[XB_TMO], 1u); break; } }
    }
    nloc = mine > 0u ? mine : 1u; nx = cnt > 0u ? cnt : 1u;
}

__device__ __forceinline__ void xcd_barrier(const XcdBarrier& b) {
    asm volatile("s_waitcnt vmcnt(0)" ::: "memory");
    __syncthreads();
    if (threadIdx.x == 0) {
        unsigned* bar = b.bar;
        __builtin_amdgcn_s_waitcnt(0);
        unsigned nloc = b.st[0], nx = b.st[1];
        if (nloc == 0u) { xcd_barrier_complete(bar, b.x, nloc, nx); b.st[0] = nloc; b.st[1] = nx; }
        const unsigned old = xb_add(&bar[XB_XSUB(b.x)], 1u);
        const unsigned gen = old / nloc;
        if (old + 1u == (gen + 1u) * nloc) {
            __builtin_amdgcn_fence(__ATOMIC_RELEASE, "agent");
            asm volatile("s_waitcnt vmcnt(0)" ::: "memory");
            const unsigned og = xb_add(&bar[XB_TOP], 1u);
            const unsigned tg = og / nx;
            if (og + 1u == (tg + 1u) * nx) xb_add(&bar[XB_TOPGEN], 1u);
            else XB_SPIN(xb_ld(&bar[XB_TOPGEN]) == tg, bar);
            __builtin_amdgcn_fence(__ATOMIC_ACQUIRE, "agent");
            xb_add(&bar[XB_XGEN(b.x)], 1u);
            asm volatile("s_waitcnt vmcnt(0)" ::: "memory");
        } else {
            XB_SPIN(xb_ld(&bar[XB_XGEN(b.x)]) == gen, bar);
            __builtin_amdgcn_fence(__ATOMIC_ACQUIRE, "agent");
            asm volatile("s_waitcnt vmcnt(0)" ::: "memory");
        }
    }
    __syncthreads();
}


__global__ void __launch_bounds__(512) fwd_kernel(Params p) {
    extern __shared__ __attribute__((aligned(16))) unsigned char lds_raw[];
    LAS unsigned char* lds = (LAS unsigned char*)lds_raw;
    const int G = gridDim.x, bid = blockIdx.x;
    const int NGW = G * 8;
#define PHASE_IDS int tid = threadIdx.x; asm volatile("" : "+v"(tid)); const int lane = tid & 63; const int wave = __builtin_amdgcn_readfirstlane(tid >> 6); const int gw = bid * 8 + wave; (void)lane; (void)gw;
    unsigned char* ws = p.ws;
    unsigned* ctl = (unsigned*)(ws + WS_CTL);
    bf16_t* Win_t = (bf16_t*)(ws + WS_WIN); bf16_t* Wa_t = (bf16_t*)(ws + WS_WA); bf16_t* Wb_t = (bf16_t*)(ws + WS_WB); bf16_t* Wout_t = (bf16_t*)(ws + WS_WOUT);
    bf16_t* Wup_t = (bf16_t*)(ws + WS_WUP); bf16_t* Wdn_t = (bf16_t*)(ws + WS_WDN);
    bf16_t* HB = (bf16_t*)(ws + WS_HB); bf16_t* PROJ = (bf16_t*)(ws + WS_PROJ); bf16_t* U = (bf16_t*)(ws + WS_U); bf16_t* VT = (bf16_t*)(ws + WS_VT);
    bf16_t* OA = (bf16_t*)(ws + WS_OA); bf16_t* OB = (bf16_t*)(ws + WS_OB); bf16_t* MERGED = (bf16_t*)(ws + WS_MERGED); bf16_t* Y = (bf16_t*)(ws + WS_Y);
    float* OPART = (float*)(ws + WS_OPART); float* STASH = (float*)(ws + WS_STASH); bf16_t* SBUF = (bf16_t*)(ws + WS_SB); float* DEC = (float*)(ws + WS_DEC);
#if N_LAUNCH_MODE == 1
    cg::grid_group grid = cg::this_grid();
    volatile LAS unsigned* bst = (volatile LAS unsigned*)(lds + LDS_BYTES - 64);
    if (threadIdx.x == 0) { bst[0] = 0u; bst[1] = 0u; }
    __syncthreads();
    unsigned* barw = ctl + 4096;
    XcdBarrier xbar; xbar.bar = barw; xbar.x = 0; xbar.st = bst;
#define GRID_SYNC() do { if (ph == 1) { grid.sync(); xbar = xcd_barrier_post(barw, bst); } else xcd_barrier(xbar); } while (0)
#else
#define GRID_SYNC() do {} while (0)
#endif
    const int lo = p.ph_lo, hi = p.ph_hi;
    int ph = 0;
#define RUN_PHASE (ph >= lo && ph < hi)
#define END_PHASE do { ++ph; if (ph > lo && ph < hi) GRID_SYNC(); } while (0)

    if (RUN_PHASE) { PHASE_IDS
        if (bid == 0) { if (tid < 64) ctl[tid] = 0u; for (int i = tid; i < XCD_BAR_WORDS; i += 512) ctl[4096 + i] = 0u; }
        LAS float* scr = (LAS float*)(lds + wave * 16384);
        constexpr int I_IN = (D / 64) * (NPROJ / 32), I_SQ = (D / 64) * (D / 32), I_UP = (D / 64) * (FF / 32), I_DN = (FF / 64) * (D / 32);
        constexpr int NITEMS = I_IN + 3 * I_SQ + I_UP + I_DN;
        for (int it = gw; it < NITEMS; it += NGW) {
            int r = it;
            if (r < I_IN) { p0_transpose_item(p.in[I_WIN], D, NPROJ, Win_t, scr, r, lane, true); continue; } r -= I_IN;
            if (r < I_SQ) { p0_transpose_item(p.in[I_WPA], D, D, Wa_t, scr, r, lane, false); continue; } r -= I_SQ;
            if (r < I_SQ) { p0_transpose_item(p.in[I_WPB], D, D, Wb_t, scr, r, lane, false); continue; } r -= I_SQ;
            if (r < I_SQ) { p0_transpose_item(p.in[I_WOUT], D, D, Wout_t, scr, r, lane, false); continue; } r -= I_SQ;
            if (r < I_UP) { p0_transpose_item(p.in[I_WUP], D, FF, Wup_t, scr, r, lane, false); continue; } r -= I_UP;
            p0_transpose_item(p.in[I_WDN], FF, D, Wdn_t, scr, r, lane, false);
        }
        for (int m = gw; m < MR; m += NGW) row_prenorm(p.in[I_XP] + (size_t)m * D, p.in[I_GPRE], HB + (size_t)m * D, lane);
    }
    END_PHASE;

#pragma unroll 1
    for (int rnd = 0; rnd < NROUND; ++rnd) {
        const int T = rnd == 0 ? 4096 : 8192; const int nseq = MR / T;
        const float* xr = rnd == 0 ? p.in[I_XP] : p.in[I_XS] + (size_t)(rnd - 1) * MR * D;
        float* outr = p.out + (size_t)rnd * MR * D;
        if (RUN_PHASE) {
            pg8::Gemm g{HB, Win_t, MR, NPROJ, D}; pg8::StaticOrder S; S.init(MR, NPROJ, G, bid);
            pg8::Epi<1> E{PROJ, NPROJ, nullptr, 0, 0, VT, T};
            pg8::gemm_phase<pg8::Epi<1>, pg8::StaticOrder, true, true>(lds, g, S, E);
        }
        END_PHASE;
        if (RUN_PHASE) {
            const int nit = nseq * 8 * (T / 64);
            for (int it = bid; it < nit; it += G) { const int c = it % (T / 64), sh = it / (T / 64); hgrn_a_item(lds, PROJ, SBUF, DEC, p.in[I_LBF], p.in[I_LBB], sh / 8, sh % 8, c, T); }
        }
        END_PHASE;
        if (RUN_PHASE) {
            const int nit = nseq * 8 * 2 * 4;
            for (int it = bid; it < nit; it += G) hgrn_scan_item(SBUF, DEC, it >> 2, it & 3, T / 64);
        }
        END_PHASE;
        if (RUN_PHASE) { PHASE_IDS
            {
                const int nit = nseq * 8 * (T / 64);
                for (int it = bid; it < nit; it += G) { const int c = it % (T / 64), sh = it / (T / 64); hgrn_c_item(lds, PROJ, SBUF, OPART, p.in[I_LBF], p.in[I_LBB], sh / 8, sh % 8, c, T); }
            }
            float lam;
            { float a = p.in[I_LQ1][lane] * p.in[I_LK1][lane], b = p.in[I_LQ2][lane] * p.in[I_LK2][lane]; a = wave_sum(a); b = wave_sum(b); lam = expf(a) - expf(b) + 0.2f; }
            const int nqb = T / 256, nitems = nseq * 8 * nqb;
            LAS int* slot = (LAS int*)(lds + AT_TAB + 2048);
#ifdef PROBE_ATTN2
            for (int rep = 0; rep < 2; ++rep)
#else
            const int rep = 0;
#endif
            for (;;) {
                __syncthreads();
                if (tid == 0) *slot = (int)atomicAdd(&ctl[rnd + 8 * rep], 1u);
                __syncthreads();
                const int it = *slot;
                if (it >= nitems) break;
                const int qb = it % nqb, sh = it / nqb;
#ifndef NO_ATTN
                attn_item(lds, PROJ, VT, OA, STASH, p.in[I_RELB], p.in[I_GSUB], lam, sh / 8, sh % 8, qb, T);
#endif
            }
        }
        END_PHASE;
        if (RUN_PHASE) { PHASE_IDS
            pg8::Gemm g{OA, Wa_t, MR, D, D}; pg8::StaticOrder S; S.init(MR, D, G, bid);
            pg8::Epi<2> E{MERGED, D, PROJ, NPROJ, C_GA, nullptr, 0};
            pg8::gemm_phase<pg8::Epi<2>, pg8::StaticOrder, true, true>(lds, g, S, E);
            for (int m = gw; m < MR; m += NGW)
                row_hgrn_fin(OPART + (size_t)m * D, OPART + (size_t)MR * D + (size_t)m * D, PROJ + (size_t)m * NPROJ + C_GOG, p.in[I_GHO], OB + (size_t)m * D, lane);
        }
        END_PHASE;
        if (RUN_PHASE) {
            pg8::Gemm g{OB, Wb_t, MR, D, D}; pg8::StaticOrder S; S.init(MR, D, G, bid);
            pg8::Epi<3> E{MERGED, D, PROJ, NPROJ, C_GB, nullptr, 0};
            pg8::gemm_phase<pg8::Epi<3>, pg8::StaticOrder, true, true>(lds, g, S, E);
        }
        END_PHASE;
        if (RUN_PHASE) {
            pg8::Gemm g{MERGED, Wout_t, MR, D, D}; pg8::StaticOrder S; S.init(MR, D, G, bid);
            pg8::Epi<0> E{Y, D, nullptr, 0, 0, nullptr, 0};
            pg8::gemm_phase<pg8::Epi<0>, pg8::StaticOrder, true, true>(lds, g, S, E);
        }
        END_PHASE;
        if (RUN_PHASE) { PHASE_IDS
            for (int m = gw; m < MR; m += NGW)
                row_normres1(xr + (size_t)m * D, Y + (size_t)m * D, p.in[I_GPOST], p.in[I_GMPRE], outr + (size_t)m * D, HB + (size_t)m * D, lane);
        }
        END_PHASE;
        if (RUN_PHASE) {
            pg8::Gemm g{HB, Wup_t, MR, FF, D}; pg8::StaticOrder S; S.init(MR, FF, G, bid);
            pg8::Epi<4> E{U, FF, nullptr, 0, 0, nullptr, 0};
            pg8::gemm_phase<pg8::Epi<4>, pg8::StaticOrder, true, true>(lds, g, S, E);
        }
        END_PHASE;
        if (RUN_PHASE) {
            pg8::Gemm g{U, Wdn_t, MR, D, FF}; pg8::StaticOrder S; S.init(MR, D, G, bid);
            pg8::Epi<0> E{Y, D, nullptr, 0, 0, nullptr, 0};
            pg8::gemm_phase<pg8::Epi<0>, pg8::StaticOrder, true, true>(lds, g, S, E);
        }
        END_PHASE;
        if (RUN_PHASE) { PHASE_IDS
            for (int m = gw; m < MR; m += NGW) row_final(Y + (size_t)m * D, p.in[I_GMPOST], outr + (size_t)m * D, lane);
            if (rnd + 1 < NROUND) {
                const float* xn = p.in[I_XS] + (size_t)rnd * MR * D;
                for (int m = gw; m < MR; m += NGW) row_prenorm(xn + (size_t)m * D, p.in[I_GPRE], HB + (size_t)m * D, lane);
            }
        }
        END_PHASE;
    }
}

constexpr int NPHASES = 1 + NROUND * 11;

extern "C" void kernel_launch(void* const* d_in, const int* in_sizes, int n_in, void* d_out, int out_size, void* d_ws, size_t ws_size, hipStream_t stream) {
    static int grid = 0;
    if (grid == 0) {
        if (n_in != 21 || ws_size < WS_END) { fprintf(stderr, "kernel_launch: unexpected n_in %d / ws %zu\n", n_in, ws_size); grid = -1; return; }
        int dev = 0, cus = 0, per_cu = 0;
        hipGetDevice(&dev);
        hipDeviceGetAttribute(&cus, hipDeviceAttributeMultiprocessorCount, dev);
        hipFuncSetAttribute((const void*)fwd_kernel, hipFuncAttributeMaxDynamicSharedMemorySize, LDS_BYTES);
        hipOccupancyMaxActiveBlocksPerMultiprocessor(&per_cu, (const void*)fwd_kernel, 512, LDS_BYTES);
        if (per_cu < 1) { fprintf(stderr, "kernel_launch: occupancy query says %d blocks/CU\n", per_cu); per_cu = 1; }
        (void)hipGetLastError();
        grid = cus;
    }
    if (grid < 0) return;
    Params p{};
    for (int i = 0; i < 21; ++i) p.in[i] = (const float*)d_in[i];
    p.out = (float*)d_out; p.ws = (unsigned char*)d_ws;
#if N_LAUNCH_MODE == 1
    p.ph_lo = 0; p.ph_hi = NPHASES;
    void* args[] = {&p};
    hipError_t e = hipLaunchCooperativeKernel((const void*)fwd_kernel, dim3(grid), dim3(512), args, LDS_BYTES, stream);
    if (e != hipSuccess) fprintf(stderr, "cooperative launch failed: %s (grid %d)\n", hipGetErrorString(e), grid);
#else
    for (int i = 0; i < NPHASES; ++i) { p.ph_lo = i; p.ph_hi = i + 1; hipLaunchKernelGGL(fwd_kernel, dim3(grid), dim3(512), LDS_BYTES, stream, p); }
#endif
}
```

```cpp
#include <hip/hip_runtime.h>
#include <hip/hip_cooperative_groups.h>
#include <cstdio>
#include <cstdint>
namespace cg = cooperative_groups;

#ifndef N_LAUNCH_MODE
#define N_LAUNCH_MODE 1
#endif

#define LAS __attribute__((address_space(3)))
typedef unsigned short bf16_t;
typedef short bf16x8 __attribute__((ext_vector_type(8)));
typedef float f32x4 __attribute__((ext_vector_type(4)));
typedef float f32x16 __attribute__((ext_vector_type(16)));
typedef unsigned u32x4 __attribute__((ext_vector_type(4)));
typedef unsigned u32x2 __attribute__((ext_vector_type(2)));
typedef float f32x2_t __attribute__((ext_vector_type(2)));
typedef __bf16 bf16x2_t __attribute__((ext_vector_type(2)));

constexpr int D = 1024, NPROJ = 10240, FF = 4096;
constexpr int MR = 16384;
constexpr int NROUND = 5;
constexpr float EPS = 1e-6f;
constexpr float LOG2E = 1.4426950408889634f;
constexpr float QSCALE = 0.125f * LOG2E;
constexpr int C_AQ = 0, C_AK = 1024, C_AV = 2048, C_GQ = 3072, C_GFF = 4096, C_GFB = 5120, C_GI = 6144, C_GOG = 7168, C_GA = 8192, C_GB = 9216;

constexpr size_t MiB = 1u << 20;
constexpr size_t WS_CTL = 0;
constexpr size_t WS_WIN = 1 * MiB, WS_WA = 21 * MiB, WS_WB = 23 * MiB, WS_WOUT = 25 * MiB, WS_WUP = 27 * MiB, WS_WDN = 35 * MiB;
constexpr size_t WS_HB = 44 * MiB, WS_PROJ = 76 * MiB, WS_U = WS_PROJ, WS_VT = 396 * MiB, WS_OA = 428 * MiB, WS_OB = 460 * MiB;
constexpr size_t WS_MERGED = 492 * MiB, WS_Y = 524 * MiB, WS_OPART = 556 * MiB, WS_STASH = 684 * MiB, WS_SB = 716 * MiB, WS_DEC = 844 * MiB, WS_END = 848 * MiB;

__device__ __forceinline__ float bf2f(unsigned u) { return __uint_as_float(u << 16); }
__device__ __forceinline__ unsigned cvtpk(float lo, float hi) { f32x2_t v = {lo, hi}; bf16x2_t b = __builtin_convertvector(v, bf16x2_t); return __builtin_bit_cast(unsigned, b); }
__device__ __forceinline__ bf16_t f2bf(float f) { return (bf16_t)(cvtpk(f, 0.f) & 0xffffu); }
__device__ __forceinline__ float fexp2(float x) { return __builtin_amdgcn_exp2f(x); }
__device__ __forceinline__ float flog2(float x) { return __builtin_amdgcn_logf(x); }
__device__ __forceinline__ float frcp(float x) { return __builtin_amdgcn_rcpf(x); }
__device__ __forceinline__ float sigmoidf_(float x) { return frcp(1.f + fexp2(-x * LOG2E)); }
__device__ __forceinline__ int crow(int r, int hi) { return (r & 3) + 8 * (r >> 2) + 4 * hi; }

namespace pg8 {
constexpr int BM = 256, BK = 64, HALF = 128, HTB = HALF * BK * 2, STAGE_BYTES = 8 * HTB, NXCD = 8, WGM = 8;
__host__ __device__ __forceinline__ int lds_byte(int r, int c) { const int st = (r >> 4) * 2 + (c >> 5), rr = r & 15, cc = c & 31, ob = rr * 64 + cc * 2; return st * 1024 + (ob ^ (((ob >> 9) & 1) << 5)); }
__host__ __device__ __forceinline__ void stage_rc(int b, int& R, int& C) { const int st = b / 1024, sb = b % 1024, swz = sb ^ (((sb >> 9) & 1) << 5); R = (st >> 1) * 16 + swz / 64; C = (st & 1) * 32 + (swz % 64) / 2; }
__host__ __device__ __forceinline__ int perm32(int rho) { const int n = rho >> 4, i = rho & 15; return 8 * (i >> 2) + 4 * n + (i & 3); }
struct Unit { int pm, pn; };
struct Gemm { const bf16_t* A; const bf16_t* Bt; int M, N, K; };
struct StaticOrder {
    int nM, nN, nwg, G, c;
    __host__ __device__ void init(int M, int N, int G_, int c_) { nM = M / BM; nN = N / BM; nwg = nM * nN; G = G_; c = c_; }
    __host__ __device__ bool next(int i, Unit& u) const {
        const long L = (long)i * G + c; if (L >= nwg) return false;
        int wgid = (int)L; { const int q = nwg / NXCD, r = nwg % NXCD, xcd = wgid % NXCD, off = wgid / NXCD; wgid = (xcd < r ? xcd * (q + 1) : r * (q + 1) + (xcd - r) * q) + off; }
        const int nig = WGM * nN, gid = wgid / nig, fm = gid * WGM, gsz = (nM - fm) < WGM ? (nM - fm) : WGM;
        u.pm = fm + ((wgid % nig) % gsz); u.pn = (wgid % nig) / gsz; return true;
    }
    __device__ __forceinline__ void a_ready(const Unit&) const {}
    __device__ __forceinline__ void done(const Unit&) const {}
};

template <int MODE> struct Epi {
    static constexpr bool PERM = true, AFTER_DRAIN = false;
    bf16_t* O; int ldc; const bf16_t* G; int ldg; int gcol0; bf16_t* VT; int T;
    __device__ __forceinline__ void operator()(const f32x4 (&acc)[2][2][4][2], const Unit& u, int wr, int wc, int fr, int fq) const {
        const int row0 = u.pm * BM + wr * 64 + fr; const int colt = u.pn * BM; const int col0 = colt + wc * 32 + 8 * fq;
        if (MODE == 1 && colt >= C_AV && colt < C_AV + 1024) {
            const int s = (u.pm * BM) / T, t0 = (u.pm * BM) % T;
            const int pf = (fr & 3) | ((fr & 4) << 1) | ((fr & 8) >> 1);
#pragma unroll
            for (int ai = 0; ai < 2; ++ai)
#pragma unroll
                for (int m = 0; m < 4; ++m) { const int tpos = t0 + ai * 128 + wr * 64 + m * 16 + pf;
#pragma unroll
                    for (int bj = 0; bj < 2; ++bj) { const int head = (colt - C_AV) / 128 + bj;
#pragma unroll
                        for (int n = 0; n < 2; ++n)
#pragma unroll
                            for (int j = 0; j < 4; ++j) { const int dv = wc * 32 + 8 * fq + 4 * n + j;
                                VT[((size_t)(s * 8 + head) * 128 + dv) * T + tpos] = f2bf(acc[ai][bj][m][n][j]); } } }
            return;
        }
#pragma unroll
        for (int ai = 0; ai < 2; ++ai)
#pragma unroll
            for (int m = 0; m < 4; ++m) { const size_t row = (size_t)(row0 + ai * HALF + m * 16); bf16_t* rowp = O + row * ldc + col0;
#pragma unroll
                for (int bj = 0; bj < 2; ++bj) { f32x4 v0 = acc[ai][bj][m][0], v1 = acc[ai][bj][m][1];
                    if (MODE == 2 || MODE == 3) {
                        const u32x4 gw = *(const u32x4*)(G + row * ldg + gcol0 + col0 + bj * HALF);
                        v0[0] *= sigmoidf_(bf2f(gw[0] & 0xffffu)); v0[1] *= sigmoidf_(bf2f(gw[0] >> 16)); v0[2] *= sigmoidf_(bf2f(gw[1] & 0xffffu)); v0[3] *= sigmoidf_(bf2f(gw[1] >> 16));
                        v1[0] *= sigmoidf_(bf2f(gw[2] & 0xffffu)); v1[1] *= sigmoidf_(bf2f(gw[2] >> 16)); v1[2] *= sigmoidf_(bf2f(gw[3] & 0xffffu)); v1[3] *= sigmoidf_(bf2f(gw[3] >> 16));
                    }
                    if (MODE == 3) {
                        const u32x4 ow = *(const u32x4*)(rowp + bj * HALF);
                        v0[0] += bf2f(ow[0] & 0xffffu); v0[1] += bf2f(ow[0] >> 16); v0[2] += bf2f(ow[1] & 0xffffu); v0[3] += bf2f(ow[1] >> 16);
                        v1[0] += bf2f(ow[2] & 0xffffu); v1[1] += bf2f(ow[2] >> 16); v1[2] += bf2f(ow[3] & 0xffffu); v1[3] += bf2f(ow[3] >> 16);
                    }
                    if (MODE == 4) {
#pragma unroll
                        for (int j = 0; j < 4; ++j) { float a = fmaxf(v0[j], 0.f), b = fmaxf(v1[j], 0.f); v0[j] = a * a; v1[j] = b * b; }
                    }
                    u32x4 w; w.x = cvtpk(v0[0], v0[1]); w.y = cvtpk(v0[2], v0[3]); w.z = cvtpk(v1[0], v1[1]); w.w = cvtpk(v1[2], v1[3]);
                    *(u32x4*)(rowp + bj * HALF) = w; } }
    }
};

template <class EpiT, class Sched, bool ALIGN_EPI = false, bool SP2 = false>
__device__ __forceinline__ void gemm_phase(LAS unsigned char* lds, const Gemm g, const Sched& S, const EpiT& E) {
    int tid_ = threadIdx.x; asm volatile("" : "+v"(tid_));
    const int tid = tid_, wid = __builtin_amdgcn_readfirstlane(tid >> 6), lane = tid & 63, wr = wid >> 2, wc = wid & 3, fr = lane & 15, fq = lane >> 4;
    const int K = g.K, nt = K / BK;
    unsigned voffA[2], voffB[2];
#pragma unroll
    for (int i = 0; i < 2; ++i) { int R, C; stage_rc(tid * 16 + i * 8192, R, C); const int Rb = EpiT::PERM ? ((R & ~31) + perm32(R & 31)) : R;
        voffA[i] = (unsigned)(R * K + C) * 2u; voffB[i] = (unsigned)(Rb * K + C) * 2u; }
    const size_t kstep = (size_t)(BK * 2);
    const size_t hstep = (size_t)HALF * K * 2;
    const size_t tstep = 2 * hstep;
    const unsigned ldsw = (unsigned)wid * 1024u;
    const int aoff = lds_byte(wr * 64 + fr, fq * 8), boff = lds_byte(wc * 32 + fr, fq * 8);
#define PG8_SA(b, h) (((b) * 2 + (h)) * HTB)
#define PG8_SB(b, h) ((4 + (b) * 2 + (h)) * HTB)
#define PG8_STAGE(bufoff, gbase, voff) do { _Pragma("unroll") for (int _i = 0; _i < 2; ++_i) \
        __builtin_amdgcn_global_load_lds((const unsigned*)((const char*)(gbase) + (voff)[_i]), (LAS unsigned*)(lds + (bufoff) + ldsw + _i * 8192), 16, 0, 0); } while (0)
#define PG8_LDA(dst, b, h) do { _Pragma("unroll") for (int m = 0; m < 4; ++m) _Pragma("unroll") for (int k = 0; k < 2; ++k) dst[m][k] = *(const LAS bf16x8*)(lds + PG8_SA(b, h) + aoff + m * 2048 + k * 1024); } while (0)
#define PG8_LDB(dst, b, h) do { _Pragma("unroll") for (int n = 0; n < 2; ++n) _Pragma("unroll") for (int k = 0; k < 2; ++k) dst[n][k] = *(const LAS bf16x8*)(lds + PG8_SB(b, h) + boff + n * 2048 + k * 1024); } while (0)
#define PG8_MMA(ai, bj, At, Bt) do { __builtin_amdgcn_s_setprio(1); _Pragma("unroll") for (int m = 0; m < 4; ++m) _Pragma("unroll") for (int n = 0; n < 2; ++n) _Pragma("unroll") for (int k = 0; k < 2; ++k) \
        acc[ai][bj][m][n] = __builtin_amdgcn_mfma_f32_16x16x32_bf16(Bt[n][k], At[m][k], acc[ai][bj][m][n], 0, 0, 0); __builtin_amdgcn_s_setprio(0); } while (0)
#define PG8_WAIT_V(n) asm volatile("s_waitcnt vmcnt(" #n ")" ::: "memory")
#define PG8_WAIT_L(n) asm volatile("s_waitcnt lgkmcnt(" #n ")" ::: "memory")
#define PG8_BAR __builtin_amdgcn_s_barrier()
#define PG8_SCHED __builtin_amdgcn_sched_barrier(0)
    Unit cur, nxt; int ui = 0;
    if (!S.next(0, cur)) return;
    f32x4 acc[2][2][4][2];
#pragma unroll
    for (int a = 0; a < 2; ++a)
#pragma unroll
        for (int b = 0; b < 2; ++b)
#pragma unroll
            for (int m = 0; m < 4; ++m)
#pragma unroll
                for (int n = 0; n < 2; ++n) acc[a][b][m][n] = (f32x4){0.f, 0.f, 0.f, 0.f};
    bf16x8 At[4][2], B0[2][2], B1[2][2];
    const char* cA = (const char*)g.A + (size_t)cur.pm * tstep; const char* cB = (const char*)g.Bt + (size_t)cur.pn * tstep;
    S.a_ready(cur);
    if constexpr (SP2) {
        PG8_STAGE(PG8_SB(0, 0), cB, voffB); PG8_STAGE(PG8_SB(0, 1), cB + hstep, voffB); PG8_STAGE(PG8_SA(0, 0), cA, voffA); PG8_STAGE(PG8_SA(0, 1), cA + hstep, voffA);
        if (wr == 1) PG8_BAR;
        PG8_WAIT_V(2); PG8_BAR;
        PG8_STAGE(PG8_SB(1, 0), cB + kstep, voffB); PG8_STAGE(PG8_SA(1, 0), cA + kstep, voffA); PG8_STAGE(PG8_SB(1, 1), cB + hstep + kstep, voffB);
        PG8_WAIT_V(6); PG8_BAR;
    } else {
        PG8_STAGE(PG8_SB(0, 0), cB, voffB); PG8_STAGE(PG8_SA(0, 0), cA, voffA); PG8_STAGE(PG8_SB(0, 1), cB + hstep, voffB); PG8_STAGE(PG8_SA(0, 1), cA + hstep, voffA);
        if (wr == 1) PG8_BAR;
        PG8_WAIT_V(4); PG8_BAR;
        PG8_STAGE(PG8_SB(1, 0), cB + kstep, voffB); PG8_STAGE(PG8_SA(1, 0), cA + kstep, voffA); PG8_STAGE(PG8_SB(1, 1), cB + hstep + kstep, voffB);
        PG8_WAIT_V(6); PG8_BAR;
    }
    for (;;) {
        const bool has_next = S.next(ui + 1, nxt);
        const char* nA = has_next ? (const char*)g.A + (size_t)nxt.pm * tstep : cA; const char* nB = has_next ? (const char*)g.Bt + (size_t)nxt.pn * tstep : cB;
        for (int t = 0; t < nt; t += 2) {
            const bool last = (t == nt - 2);
            const char* a1 = cA + (size_t)(t + 1) * kstep;
            const char* a2 = last ? nA : cA + (size_t)(t + 2) * kstep; const char* b2 = last ? nB : cB + (size_t)(t + 2) * kstep;
            const char* a3 = a2 + kstep; const char* b3 = b2 + kstep;
            if (last && has_next) S.a_ready(nxt);
            if constexpr (SP2) {
            PG8_LDB(B0, 0, 0); PG8_LDB(B1, 0, 1); PG8_SCHED; PG8_LDA(At, 0, 0); PG8_STAGE(PG8_SA(1, 1), a1 + hstep, voffA);
            PG8_WAIT_V(8); PG8_WAIT_L(0); PG8_BAR; PG8_MMA(0, 0, At, B0); PG8_MMA(0, 1, At, B1); PG8_BAR; PG8_SCHED;
            PG8_LDA(At, 0, 1); PG8_STAGE(PG8_SB(0, 0), b2, voffB); PG8_STAGE(PG8_SB(0, 1), b2 + hstep, voffB); PG8_STAGE(PG8_SA(0, 0), a2, voffA);
            PG8_WAIT_V(8); PG8_WAIT_L(0); PG8_BAR; PG8_MMA(1, 0, At, B0); PG8_MMA(1, 1, At, B1); PG8_BAR; PG8_SCHED;
            PG8_LDB(B0, 1, 0); PG8_LDB(B1, 1, 1); PG8_SCHED; PG8_LDA(At, 1, 0); PG8_STAGE(PG8_SA(0, 1), a2 + hstep, voffA);
            PG8_WAIT_V(8); PG8_WAIT_L(0); PG8_BAR; PG8_MMA(0, 0, At, B0); PG8_MMA(0, 1, At, B1); PG8_BAR; PG8_SCHED;
            PG8_LDA(At, 1, 1); PG8_STAGE(PG8_SB(1, 0), b3, voffB); PG8_STAGE(PG8_SB(1, 1), b3 + hstep, voffB); PG8_STAGE(PG8_SA(1, 0), a3, voffA);
            PG8_WAIT_V(8); PG8_WAIT_L(0); PG8_BAR; PG8_MMA(1, 0, At, B0); PG8_MMA(1, 1, At, B1); PG8_BAR; PG8_SCHED;
            } else {
            PG8_LDB(B0, 0, 0); PG8_SCHED; PG8_LDA(At, 0, 0); PG8_STAGE(PG8_SA(1, 1), a1 + hstep, voffA);
            PG8_WAIT_L(8); PG8_BAR; PG8_WAIT_L(0); PG8_MMA(0, 0, At, B0); PG8_BAR; PG8_SCHED;
            PG8_LDB(B1, 0, 1); PG8_STAGE(PG8_SB(0, 0), b2, voffB);
            PG8_BAR; PG8_WAIT_L(0); PG8_MMA(0, 1, At, B1); PG8_BAR;
            PG8_LDA(At, 0, 1); PG8_STAGE(PG8_SA(0, 0), a2, voffA);
            PG8_BAR; PG8_WAIT_L(0); PG8_MMA(1, 0, At, B0); PG8_BAR; PG8_SCHED;
            PG8_STAGE(PG8_SB(0, 1), b2 + hstep, voffB);
            PG8_WAIT_V(6); PG8_BAR; PG8_MMA(1, 1, At, B1); PG8_BAR;
            PG8_LDB(B0, 1, 0); PG8_SCHED; PG8_LDA(At, 1, 0); PG8_STAGE(PG8_SA(0, 1), a2 + hstep, voffA);
            PG8_WAIT_L(8); PG8_BAR; PG8_WAIT_L(0); PG8_MMA(0, 0, At, B0); PG8_BAR; PG8_SCHED;
            PG8_LDB(B1, 1, 1); PG8_STAGE(PG8_SB(1, 0), b3, voffB);
            PG8_BAR; PG8_WAIT_L(0); PG8_MMA(0, 1, At, B1); PG8_BAR;
            PG8_LDA(At, 1, 1); PG8_STAGE(PG8_SA(1, 0), a3, voffA);
            PG8_BAR; PG8_WAIT_L(0); PG8_MMA(1, 0, At, B0); PG8_BAR; PG8_SCHED;
            PG8_STAGE(PG8_SB(1, 1), b3 + hstep, voffB);
            PG8_WAIT_V(6); PG8_BAR; PG8_MMA(1, 1, At, B1); PG8_BAR;
            }
        }
        if constexpr (ALIGN_EPI) { if (wr == 0) PG8_BAR; }
        if constexpr (!EpiT::AFTER_DRAIN) { E(acc, cur, wr, wc, fr, fq); S.done(cur); }
        if (!has_next) break;
#pragma unroll
        for (int a = 0; a < 2; ++a)
#pragma unroll
            for (int b = 0; b < 2; ++b)
#pragma unroll
                for (int m = 0; m < 4; ++m)
#pragma unroll
                    for (int n = 0; n < 2; ++n) acc[a][b][m][n] = (f32x4){0.f, 0.f, 0.f, 0.f};
        cur = nxt; cA = nA; cB = nB; ++ui;
        if constexpr (ALIGN_EPI) { if (wr == 1) PG8_BAR; }
    }
    PG8_WAIT_V(0);
    if constexpr (!ALIGN_EPI) { if (wr == 0) PG8_BAR; }
    PG8_BAR;
#undef PG8_SA
#undef PG8_SB
#undef PG8_STAGE
#undef PG8_LDA
#undef PG8_LDB
#undef PG8_MMA
#undef PG8_WAIT_V
#undef PG8_WAIT_L
#undef PG8_BAR
#undef PG8_SCHED
}
}

struct Params {
    const float* in[21];
    float* out;
    unsigned char* ws;
    int ph_lo, ph_hi;
};
enum { I_XP = 0, I_XS, I_RELB, I_GPRE, I_WIN, I_LQ1, I_LK1, I_LQ2, I_LK2, I_GSUB, I_LBF, I_LBB, I_GHO, I_WPA, I_WPB, I_WOUT, I_GPOST, I_GMPRE, I_WUP, I_WDN, I_GMPOST };

constexpr int LDS_BYTES = 151552;

__device__ __forceinline__ float wave_sum(float v) {
#pragma unroll
    for (int o = 1; o < 64; o <<= 1) v += __shfl_xor(v, o);
    return v;
}
__device__ __forceinline__ float half_sum(float v) {
#pragma unroll
    for (int o = 1; o < 32; o <<= 1) v += __shfl_xor(v, o);
    return v;
}

__device__ __forceinline__ void p0_transpose_item(const float* W, int K, int N, bf16_t* WT, LAS float* scr, int item, int lane, bool scale_q) {
    const int nblk = N / 32, kb = item / nblk, nb = item % nblk, k0 = 64 * kb, n0 = 32 * nb;
    const float sc = (scale_q && n0 < 1024) ? QSCALE : 1.f;
#pragma unroll 8
    for (int i = 0; i < 32; ++i) { const int kk = 2 * i + (lane >> 5); scr[kk * 33 + (lane & 31)] = W[(size_t)(k0 + kk) * N + n0 + (lane & 31)] * sc; }
    asm volatile("s_waitcnt lgkmcnt(0)" ::: "memory");
    const int c = lane & 7;
#pragma unroll
    for (int j = 0; j < 4; ++j) { const int n = (lane >> 3) + 8 * j; const LAS float* s = scr + (8 * c) * 33 + n;
        u32x4 o; o.x = cvtpk(s[0 * 33], s[1 * 33]); o.y = cvtpk(s[2 * 33], s[3 * 33]); o.z = cvtpk(s[4 * 33], s[5 * 33]); o.w = cvtpk(s[6 * 33], s[7 * 33]);
        *(u32x4*)(WT + (size_t)(n0 + n) * K + k0 + 8 * c) = o; }
    asm volatile("s_waitcnt lgkmcnt(0)" ::: "memory");
}

__device__ __forceinline__ void row_prenorm(const float* xrow, const float* g, bf16_t* orow, int lane) {
    f32x4 v[4]; float s = 0.f;
#pragma unroll
    for (int j = 0; j < 4; ++j) { v[j] = *(const f32x4*)(xrow + 4 * lane + 256 * j); s += (v[j].x * v[j].x + v[j].y * v[j].y) + (v[j].z * v[j].z + v[j].w * v[j].w); }
    const float r = 1.f / sqrtf(wave_sum(s) * (1.f / D) + EPS);
#pragma unroll
    for (int j = 0; j < 4; ++j) { const f32x4 gg = *(const f32x4*)(g + 4 * lane + 256 * j);
        u32x2 w; w.x = cvtpk(v[j].x * r * gg.x, v[j].y * r * gg.y); w.y = cvtpk(v[j].z * r * gg.z, v[j].w * r * gg.w);
        *(u32x2*)(orow + 4 * lane + 256 * j) = w; }
}
__device__ __forceinline__ void row_normres1(const float* xrow, const bf16_t* yrow, const float* g1, const float* g2, float* outrow, bf16_t* hrow, int lane) {
    f32x4 y[4]; float s = 0.f;
#pragma unroll
    for (int j = 0; j < 4; ++j) { const u32x2 w = *(const u32x2*)(yrow + 4 * lane + 256 * j);
        y[j] = (f32x4){bf2f(w.x & 0xffffu), bf2f(w.x >> 16), bf2f(w.y & 0xffffu), bf2f(w.y >> 16)};
        s += (y[j].x * y[j].x + y[j].y * y[j].y) + (y[j].z * y[j].z + y[j].w * y[j].w); }
    const float r = 1.f / sqrtf(wave_sum(s) * (1.f / D) + EPS);
    float s2 = 0.f;
#pragma unroll
    for (int j = 0; j < 4; ++j) { const f32x4 xx = *(const f32x4*)(xrow + 4 * lane + 256 * j); const f32x4 gg = *(const f32x4*)(g1 + 4 * lane + 256 * j);
        y[j] = xx + y[j] * r * gg; *(f32x4*)(outrow + 4 * lane + 256 * j) = y[j];
        s2 += (y[j].x * y[j].x + y[j].y * y[j].y) + (y[j].z * y[j].z + y[j].w * y[j].w); }
    const float r2 = 1.f / sqrtf(wave_sum(s2) * (1.f / D) + EPS);
#pragma unroll
    for (int j = 0; j < 4; ++j) { const f32x4 gg = *(const f32x4*)(g2 + 4 * lane + 256 * j);
        u32x2 w; w.x = cvtpk(y[j].x * r2 * gg.x, y[j].y * r2 * gg.y); w.y = cvtpk(y[j].z * r2 * gg.z, y[j].w * r2 * gg.w);
        *(u32x2*)(hrow + 4 * lane + 256 * j) = w; }
}
__device__ __forceinline__ void row_final(const bf16_t* yrow, const float* g, float* outrow, int lane) {
    f32x4 y[4]; float s = 0.f;
#pragma unroll
    for (int j = 0; j < 4; ++j) { const u32x2 w = *(const u32x2*)(yrow + 4 * lane + 256 * j);
        y[j] = (f32x4){bf2f(w.x & 0xffffu), bf2f(w.x >> 16), bf2f(w.y & 0xffffu), bf2f(w.y >> 16)};
        s += (y[j].x * y[j].x + y[j].y * y[j].y) + (y[j].z * y[j].z + y[j].w * y[j].w); }
    const float r = 1.f / sqrtf(wave_sum(s) * (1.f / D) + EPS);
#pragma unroll
    for (int j = 0; j < 4; ++j) { const f32x4 xx = *(const f32x4*)(outrow + 4 * lane + 256 * j); const f32x4 gg = *(const f32x4*)(g + 4 * lane + 256 * j);
        *(f32x4*)(outrow + 4 * lane + 256 * j) = xx + y[j] * r * gg; }
}
__device__ __forceinline__ void row_hgrn_fin(const float* of, const float* ob, const bf16_t* ogrow, const float* gout, bf16_t* orow, int lane) {
#pragma unroll
    for (int j = 0; j < 4; ++j) {
        const int col = 4 * lane + 256 * j;
        f32x4 v = *(const f32x4*)(of + col) + *(const f32x4*)(ob + col);
        const float ss = half_sum((v.x * v.x + v.y * v.y) + (v.z * v.z + v.w * v.w));
        const float r = 1.f / sqrtf(ss * (1.f / 128.f) + EPS);
        const f32x4 gg = *(const f32x4*)(gout + (col & 127));
        const u32x2 w = *(const u32x2*)(ogrow + col);
        const float g0 = bf2f(w.x & 0xffffu), g1 = bf2f(w.x >> 16), g2 = bf2f(w.y & 0xffffu), g3 = bf2f(w.y >> 16);
        u32x2 o; o.x = cvtpk(v.x * r * gg.x * g0 * sigmoidf_(g0), v.y * r * gg.y * g1 * sigmoidf_(g1));
        o.y = cvtpk(v.z * r * gg.z * g2 * sigmoidf_(g2), v.w * r * gg.w * g3 * sigmoidf_(g3));
        *(u32x2*)(orow + col) = o;
    }
}

constexpr int AT_K0 = 0, AT_V0 = 24576, AT_TAB = 73728;
__device__ __forceinline__ int t5_bucket_dev(int rel) {
    const int n = rel < 0 ? -rel : rel; const int ret = rel > 0 ? 16 : 0;
    int b;
    if (n < 8) b = n; else if (n < 12) b = 8; else if (n < 16) b = 9; else if (n < 23) b = 10; else if (n < 32) b = 11; else if (n < 46) b = 12; else if (n < 64) b = 13; else if (n < 91) b = 14; else b = 15;
    return ret + b;
}
__device__ __forceinline__ void attn_item(LAS unsigned char* lds, const bf16_t* proj, const bf16_t* vT, bf16_t* oa, float* stash, const float* relb, const float* gsub, float lam,
                                          int s, int h, int qb, int T) {
    int tid_ = threadIdx.x; asm volatile("" : "+v"(tid_));
    const int tid = tid_, lane = tid & 63, r32 = lane & 31, hi = lane >> 5; const int wid = __builtin_amdgcn_readfirstlane(tid >> 6);
    const int NT = T / 64;
    const size_t rowbase = (size_t)s * T;
    LAS float* tab = (LAS float*)(lds + AT_TAB);
    __syncthreads();
    for (int i = tid; i < 257; i += 512) tab[i] = relb[t5_bucket_dev(i - 128) * 8 + h] * LOG2E;
    const float EL = fexp2(relb[15 * 8 + h] * LOG2E), ERi = fexp2(-relb[31 * 8 + h] * LOG2E);
    const int qlo = qb * 256 + wid * 32;
    const size_t qrow = rowbase + qlo + r32;
    const bf16_t* vsrc[2];
#pragma unroll
    for (int i = 0; i < 2; ++i) { const int cv = wid + 8 * i; vsrc[i] = vT + ((size_t)(s * 8 + h) * 128 + 32 * (cv >> 2) + (lane & 31)) * T + 16 * (cv & 3) + 8 * (lane >> 5); }
#define GLDS(gp, off) __builtin_amdgcn_global_load_lds((const unsigned*)(gp), (LAS unsigned*)(lds + (off)), 16, 0, 0)
#define WAITBAR(N) asm volatile("s_waitcnt vmcnt(" #N ") lgkmcnt(0)\n\ts_barrier" ::: "memory")
    float* st = stash + ((size_t)blockIdx.x * 512 + tid) * 64;
#define TCLS(t) (((t) * 64 + 63 - qlo <= -128) ? 0 : (((t) * 64 - (qlo + 31) >= 128) ? 2 : 1))
#pragma unroll 1
    for (int c = 0; c < 2; ++c) {
        bf16x8 qr[4];
#pragma unroll
        for (int d0 = 0; d0 < 4; ++d0) qr[d0] = *(const bf16x8*)(proj + qrow * NPROJ + C_AQ + h * 128 + c * 64 + 16 * d0 + 8 * hi);
        const bf16_t* ksrc = proj + (rowbase + lane) * NPROJ + C_AK + h * 128 + c * 64 + wid * 8;
        f32x16 o[4];
#pragma unroll
        for (int i = 0; i < 4; ++i)
#pragma unroll
            for (int r = 0; r < 16; ++r) o[i][r] = 0.f;
        float l = 0.f;
        __syncthreads();
        {
            GLDS(ksrc, AT_K0 + wid * 1024); GLDS(ksrc + (size_t)64 * NPROJ, AT_K0 + 8192 + wid * 1024);
            GLDS(vsrc[0], AT_V0 + wid * 1024); GLDS(vsrc[1], AT_V0 + (wid + 8) * 1024);
            GLDS(vsrc[0], AT_V0 + 2 * 16384 + wid * 1024); GLDS(vsrc[1], AT_V0 + 2 * 16384 + (wid + 8) * 1024);
        }
        WAITBAR(0);
        u32x4 pwp[4];
#pragma unroll
        for (int i = 0; i < 4; ++i) pwp[i] = (u32x4){0u, 0u, 0u, 0u};
        int cls_m1 = TCLS(0), cls_m2 = cls_m1;
        int s0 = 0, s1 = 1, s2 = 2;
#define SB0() __builtin_amdgcn_sched_barrier(0)
#pragma unroll 1
        for (int kt = 0; kt < NT; ++kt) {
            {
                const int ktk = min(kt + 2, NT - 1), ktv = min(kt + 1, NT - 1);
                GLDS(ksrc + (size_t)ktk * 64 * NPROJ, AT_K0 + s2 * 8192 + wid * 1024);
                GLDS(vsrc[0] + ktv * 64, AT_V0 + s1 * 16384 + wid * 1024); GLDS(vsrc[1] + ktv * 64, AT_V0 + s1 * 16384 + (wid + 8) * 1024);
            }
            const int cls = TCLS(kt);
            if (cls != cls_m1) { l *= (cls_m1 == 0) ? EL : ERi; }
            if (cls_m1 != cls_m2) { const float f = (cls_m2 == 0) ? EL : ERi;
#pragma unroll
                for (int i = 0; i < 4; ++i)
#pragma unroll
                    for (int r = 0; r < 16; ++r) o[i][r] *= f; }
            cls_m2 = cls_m1; cls_m1 = cls;
            const LAS unsigned char* Kb = lds + AT_K0 + s0 * 8192; const LAS unsigned char* Vb = lds + AT_V0 + s2 * 16384 + hi * 512 + r32 * 16;
            bf16x8 vf[2][4];
#pragma unroll
            for (int dvb = 0; dvb < 4; ++dvb) vf[0][dvb] = *(const LAS bf16x8*)(Vb + (dvb * 4 + 0) * 1024);
            f32x16 pc0, pc1;
#pragma unroll
            for (int r = 0; r < 16; ++r) { pc0[r] = 0.f; pc1[r] = 0.f; }
            {
                bf16x8 ka[4][2];
#pragma unroll
                for (int d0 = 0; d0 < 4; ++d0) { ka[d0][0] = *(const LAS bf16x8*)(Kb + d0 * 2048 + hi * 1024 + r32 * 16); ka[d0][1] = *(const LAS bf16x8*)(Kb + d0 * 2048 + hi * 1024 + 512 + r32 * 16); }
#pragma unroll
                for (int d0 = 0; d0 < 4; ++d0) {
                    pc0 = __builtin_amdgcn_mfma_f32_32x32x16_bf16(ka[d0][0], qr[d0], pc0, 0, 0, 0);
                    pc1 = __builtin_amdgcn_mfma_f32_32x32x16_bf16(ka[d0][1], qr[d0], pc1, 0, 0, 0);
                }
            }
            if (cls == 1) {
                const int qpos = qlo + r32, k0 = kt * 64;
#pragma unroll
                for (int r = 0; r < 16; ++r) {
                    const int rel0 = k0 + crow(r, hi) - qpos, rel1 = rel0 + 32;
                    const int i0 = min(max(rel0, -128), 128) + 128, i1 = min(max(rel1, -128), 128) + 128;
                    pc0[r] += tab[i0]; pc1[r] += tab[i1];
                }
            }
            SB0();
#pragma unroll
            for (int ks = 0; ks < 4; ++ks) {
                if (ks < 3) {
#pragma unroll
                    for (int dvb = 0; dvb < 4; ++dvb) vf[(ks + 1) & 1][dvb] = *(const LAS bf16x8*)(Vb + (dvb * 4 + ks + 1) * 1024);
                }
#pragma unroll
                for (int dvb = 0; dvb < 4; ++dvb) {
                    o[dvb] = __builtin_amdgcn_mfma_f32_32x32x16_bf16(vf[ks & 1][dvb], __builtin_bit_cast(bf16x8, pwp[ks]), o[dvb], 0, 0, 0);
                    const int g = ks * 4 + dvb;
                    if (g < 8) { pc0[2 * g] = fexp2(pc0[2 * g]); pc0[2 * g + 1] = fexp2(pc0[2 * g + 1]); }
                    else { pc1[2 * g - 16] = fexp2(pc1[2 * g - 16]); pc1[2 * g - 15] = fexp2(pc1[2 * g - 15]); }
                    SB0();
                }
            }
            float sa = 0.f, sb = 0.f;
#pragma unroll
            for (int r = 0; r < 16; ++r) { sa += pc0[r]; sb += pc1[r]; }
            l += sa + sb;
#pragma unroll
            for (int i = 0; i < 4; ++i) { pwp[0][i] = cvtpk(pc0[2 * i], pc0[2 * i + 1]); pwp[1][i] = cvtpk(pc0[8 + 2 * i], pc0[8 + 2 * i + 1]);
                                          pwp[2][i] = cvtpk(pc1[2 * i], pc1[2 * i + 1]); pwp[3][i] = cvtpk(pc1[8 + 2 * i], pc1[8 + 2 * i + 1]); }
            WAITBAR(3);
            { const int t_ = s0; s0 = s1; s1 = s2; s2 = t_; }
        }
        {
            if (cls_m1 != cls_m2) { const float f = (cls_m2 == 0) ? EL : ERi;
#pragma unroll
                for (int i = 0; i < 4; ++i)
#pragma unroll
                    for (int r = 0; r < 16; ++r) o[i][r] *= f; }
            asm volatile("s_waitcnt vmcnt(0)" ::: "memory");
            const LAS unsigned char* Vb = lds + AT_V0 + s2 * 16384;
#pragma unroll
            for (int ks = 0; ks < 4; ++ks)
#pragma unroll
                for (int dvb = 0; dvb < 4; ++dvb) {
                    const bf16x8 vf = *(const LAS bf16x8*)(Vb + (dvb * 4 + ks) * 1024 + hi * 512 + r32 * 16);
                    o[dvb] = __builtin_amdgcn_mfma_f32_32x32x16_bf16(vf, __builtin_bit_cast(bf16x8, pwp[ks]), o[dvb], 0, 0, 0);
                }
        }
#undef SB0
        l += __shfl_xor(l, 32);
        const float rl = 1.f / l;
        if (c == 0) {
#pragma unroll
            for (int i = 0; i < 4; ++i)
#pragma unroll
                for (int g = 0; g < 4; ++g) *(f32x4*)(st + i * 16 + 4 * g) = (f32x4){o[i][4 * g] * rl, o[i][4 * g + 1] * rl, o[i][4 * g + 2] * rl, o[i][4 * g + 3] * rl};
        } else {
            float ss = 0.f;
#pragma unroll
            for (int i = 0; i < 4; ++i)
#pragma unroll
                for (int g = 0; g < 4; ++g) { const f32x4 s0 = *(const f32x4*)(st + i * 16 + 4 * g);
#pragma unroll
                    for (int j = 0; j < 4; ++j) { const float v = s0[j] - lam * (o[i][4 * g + j] * rl); o[i][4 * g + j] = v; ss += v * v; } }
            ss += __shfl_xor(ss, 32);
            const float rn = 0.8f / sqrtf(ss * (1.f / 128.f) + EPS);
            bf16_t* orow = oa + qrow * D + h * 128;
#pragma unroll
            for (int i = 0; i < 4; ++i)
#pragma unroll
                for (int g = 0; g < 4; ++g) { const int dv = 32 * i + 8 * g + 4 * hi; const f32x4 gg = *(const f32x4*)(gsub + dv);
                    u32x2 w; w.x = cvtpk(o[i][4 * g] * rn * gg.x, o[i][4 * g + 1] * rn * gg.y); w.y = cvtpk(o[i][4 * g + 2] * rn * gg.z, o[i][4 * g + 3] * rn * gg.w);
                    *(u32x2*)(orow + dv) = w; }
        }
    }
#undef TCLS
#undef GLDS
#undef WAITBAR
}

constexpr int HG_QT = 0, HG_KT = 17408, HG_QH = 34816, HG_VT = 52224, HG_DIR = 70656;
constexpr int HG_HS = 2 * HG_DIR;
static_assert(HG_HS + 2048 <= LDS_BYTES, "HGRN LDS map");
struct HgIds { int tid, lane, r32, hi, wid, d, k, half, wq; };
__device__ __forceinline__ HgIds hg_ids() {
    int tid_ = threadIdx.x; asm volatile("" : "+v"(tid_));
    HgIds I; I.tid = tid_; I.lane = tid_ & 63; I.r32 = I.lane & 31; I.hi = I.lane >> 5; I.wid = __builtin_amdgcn_readfirstlane(tid_ >> 6);
    I.d = tid_ >> 8; I.k = tid_ & 127; I.half = (tid_ >> 7) & 1; I.wq = I.wid & 3; return I;
}
__device__ __forceinline__ void hgrn_a_item(LAS unsigned char* lds, const bf16_t* proj, bf16_t* SB, float* DEC, const float* lbfw, const float* lbbw, int s, int h, int c, int T) {
    const HgIds I = hg_ids(); const int d = I.d, k = I.k, half = I.half, r32 = I.r32, hi = I.hi;
    LAS unsigned char* L = lds + d * HG_DIR; LAS float* hs = (LAS float*)(lds + HG_HS);
    const float* lbw = d ? lbbw : lbfw;
    const float lb = sigmoidf_(lbw[h * 128 + k] - lbw[1024 + h * 128 + k]), omlb = 1.f - lb;
    const size_t rowbase = (size_t)s * T; const int NC = T / 64;
    const int zcol = (d ? C_GFB : C_GFF) + h * 128 + k, vcol = C_GI + h * 128 + k;
    float g2[32], kk[32]; float run = 0.f;
    {
        unsigned zr[32], vr[32];
#pragma unroll
        for (int ii = 0; ii < 32; ++ii) { const int i = 32 * half + ii; const int tk = d ? (T - 1 - (64 * c + i)) : (64 * c + i); const bf16_t* rp = proj + (rowbase + tk) * NPROJ;
            zr[ii] = rp[zcol]; vr[ii] = rp[vcol]; }
#pragma unroll
        for (int q4 = 0; q4 < 4; ++q4) { u32x4 w;
#pragma unroll
            for (int e = 0; e < 4; ++e) w[e] = vr[8 * q4 + 2 * e] | (vr[8 * q4 + 2 * e + 1] << 16);
            *(LAS u32x4*)(L + HG_VT + k * 144 + (32 * half + 8 * q4) * 2) = w; }
#pragma unroll
        for (int ii = 0; ii < 32; ++ii) { const float sg = sigmoidf_(bf2f(zr[ii])); const float f = lb + omlb * sg;
            kk[ii] = omlb * (1.f - sg); run += flog2(f); g2[ii] = run; }
    }
    hs[(d * 2 + half) * 128 + k] = run;
    __syncthreads();
    const float h0 = hs[(d * 2 + 0) * 128 + k], blast = h0 + hs[(d * 2 + 1) * 128 + k];
    const float boff = half ? h0 : 0.f;
    const size_t slot = ((size_t)((s * 8 + h) * 2 + d)) * NC + c;
    if (half == 0) DEC[slot * 128 + k] = fexp2(blast);
    {
        unsigned ktt[32];
#pragma unroll
        for (int ii = 0; ii < 32; ++ii) ktt[ii] = f2bf(kk[ii] * fexp2(blast - (g2[ii] + boff)));
#pragma unroll
        for (int q4 = 0; q4 < 4; ++q4) { u32x4 w;
#pragma unroll
            for (int e = 0; e < 4; ++e) w[e] = ktt[8 * q4 + 2 * e] | (ktt[8 * q4 + 2 * e + 1] << 16);
            *(LAS u32x4*)(L + HG_QT + k * 144 + (32 * half + 8 * q4) * 2) = w; }
    }
    __syncthreads();
    f32x16 acc[4];
#pragma unroll
    for (int i = 0; i < 4; ++i)
#pragma unroll
        for (int r = 0; r < 16; ++r) acc[i][r] = 0.f;
#pragma unroll
    for (int ks = 0; ks < 4; ++ks) {
        const bf16x8 vf = *(const LAS bf16x8*)(L + HG_VT + (32 * I.wq + r32) * 144 + (16 * ks + 8 * hi) * 2);
#pragma unroll
        for (int kb = 0; kb < 4; ++kb) {
            const bf16x8 kf = *(const LAS bf16x8*)(L + HG_QT + (32 * kb + r32) * 144 + (16 * ks + 8 * hi) * 2);
            acc[kb] = __builtin_amdgcn_mfma_f32_32x32x16_bf16(vf, kf, acc[kb], 0, 0, 0);
        }
    }
    bf16_t* sp = SB + slot * 16384;
#pragma unroll
    for (int kb = 0; kb < 4; ++kb)
#pragma unroll
        for (int r = 0; r < 16; ++r) sp[(32 * I.wq + crow(r, hi)) * 128 + 32 * kb + r32] = f2bf(acc[kb][r]);
    __syncthreads();
}
__device__ __forceinline__ void hgrn_scan_item(bf16_t* SB, const float* DEC, int chain, int part, int NC) {
    int tid_ = threadIdx.x; asm volatile("" : "+v"(tid_));
    const int e = part * 512 + tid_, dv = e >> 4, k8 = (e & 15) * 8;
    bf16_t* sp = SB + (size_t)chain * NC * 16384 + dv * 128 + k8; const float* dp = DEC + (size_t)chain * NC * 128 + k8;
    float st[8];
#pragma unroll
    for (int j = 0; j < 8; ++j) st[j] = 0.f;
#pragma unroll 4
    for (int c = 0; c < NC; ++c) {
        const u32x4 w = *(const u32x4*)(sp + (size_t)c * 16384);
        const f32x4 d0 = *(const f32x4*)(dp + (size_t)c * 128), d1 = *(const f32x4*)(dp + (size_t)c * 128 + 4);
        u32x4 o; o.x = cvtpk(st[0], st[1]); o.y = cvtpk(st[2], st[3]); o.z = cvtpk(st[4], st[5]); o.w = cvtpk(st[6], st[7]);
        *(u32x4*)(sp + (size_t)c * 16384) = o;
        st[0] = d0.x * st[0] + bf2f(w.x & 0xffffu); st[1] = d0.y * st[1] + bf2f(w.x >> 16); st[2] = d0.z * st[2] + bf2f(w.y & 0xffffu); st[3] = d0.w * st[3] + bf2f(w.y >> 16);
        st[4] = d1.x * st[4] + bf2f(w.z & 0xffffu); st[5] = d1.y * st[5] + bf2f(w.z >> 16); st[6] = d1.z * st[6] + bf2f(w.w & 0xffffu); st[7] = d1.w * st[7] + bf2f(w.w >> 16);
    }
}
__device__ __forceinline__ void hgrn_c_item(LAS unsigned char* lds, const bf16_t* proj, const bf16_t* SB, float* opart, const float* lbfw, const float* lbbw, int s, int h, int c, int T) {
    const HgIds I = hg_ids(); const int d = I.d, k = I.k, half = I.half, r32 = I.r32, hi = I.hi, dvb = I.wq;
    LAS unsigned char* L = lds + d * HG_DIR; LAS float* hs = (LAS float*)(lds + HG_HS);
    const float* lbw = d ? lbbw : lbfw;
    const float lb = sigmoidf_(lbw[h * 128 + k] - lbw[1024 + h * 128 + k]), omlb = 1.f - lb;
    const size_t rowbase = (size_t)s * T; const int NC = T / 64;
    const int zcol = (d ? C_GFB : C_GFF) + h * 128 + k, qcol = C_GQ + h * 128 + k, vcol = C_GI + h * 128 + k;
    const size_t slot = ((size_t)((s * 8 + h) * 2 + d)) * NC + c;
    bf16x8 sf[8];
    { const bf16_t* sp = SB + slot * 16384 + (32 * dvb + r32) * 128 + 8 * hi;
#pragma unroll
      for (int ks = 0; ks < 8; ++ks) sf[ks] = *(const bf16x8*)(sp + 16 * ks); }
    float g2[32], kk[32]; unsigned qv[32]; float run = 0.f;
    {
        unsigned zr[32], vr[32];
#pragma unroll
        for (int ii = 0; ii < 32; ++ii) { const int i = 32 * half + ii; const int tk = d ? (T - 1 - (64 * c + i)) : (64 * c + i); const bf16_t* rp = proj + (rowbase + tk) * NPROJ;
            zr[ii] = rp[zcol]; qv[ii] = rp[qcol]; vr[ii] = rp[vcol]; }
#pragma unroll
        for (int q4 = 0; q4 < 4; ++q4) { u32x4 w;
#pragma unroll
            for (int e = 0; e < 4; ++e) w[e] = vr[8 * q4 + 2 * e] | (vr[8 * q4 + 2 * e + 1] << 16);
            *(LAS u32x4*)(L + HG_VT + k * 144 + (32 * half + 8 * q4) * 2) = w; }
#pragma unroll
        for (int ii = 0; ii < 32; ++ii) { const float sg = sigmoidf_(bf2f(zr[ii])); const float f = lb + omlb * sg;
            kk[ii] = omlb * (1.f - sg); run += flog2(f); g2[ii] = run; }
    }
    hs[(d * 2 + half) * 128 + k] = run;
    __syncthreads();
    const float cref = hs[(d * 2 + 0) * 128 + k];
    const float boff = half ? cref : 0.f;
#pragma unroll
    for (int ii = 0; ii < 32; ++ii) { const int i = 32 * half + ii; const float b = g2[ii] + boff, bb = b - cref;
        const float e1 = fexp2(fminf(bb, 100.f)), e2 = fexp2(fminf(-bb, 100.f)); const float qf = bf2f(qv[ii]);
        *(LAS bf16_t*)(L + HG_QT + i * 272 + k * 2) = f2bf(qf * e1); *(LAS bf16_t*)(L + HG_KT + i * 272 + k * 2) = f2bf(kk[ii] * e2);
        *(LAS bf16_t*)(L + HG_QH + i * 272 + k * 2) = f2bf(qf * fexp2(b)); }
    __syncthreads();
    f32x16 am;
#pragma unroll
    for (int r = 0; r < 16; ++r) am[r] = 0.f;
    const int tb = (dvb == 0 || dvb == 3) ? 0 : 1, sb = (dvb >= 2) ? 1 : 0;
    if (dvb < 3) {
#pragma unroll
        for (int ks = 0; ks < 8; ++ks) {
            const bf16x8 a = *(const LAS bf16x8*)(L + HG_QT + (32 * tb + r32) * 272 + (16 * ks + 8 * hi) * 2);
            const bf16x8 b = *(const LAS bf16x8*)(L + HG_KT + (32 * sb + r32) * 272 + (16 * ks + 8 * hi) * 2);
            am = __builtin_amdgcn_mfma_f32_32x32x16_bf16(a, b, am, 0, 0, 0);
        }
    }
    f32x16 o[2];
#pragma unroll
    for (int i = 0; i < 2; ++i)
#pragma unroll
        for (int r = 0; r < 16; ++r) o[i][r] = 0.f;
#pragma unroll
    for (int ks = 0; ks < 8; ++ks)
#pragma unroll
        for (int tb2 = 0; tb2 < 2; ++tb2) {
            const bf16x8 af = *(const LAS bf16x8*)(L + HG_QH + (32 * tb2 + r32) * 272 + (16 * ks + 8 * hi) * 2);
            o[tb2] = __builtin_amdgcn_mfma_f32_32x32x16_bf16(af, sf[ks], o[tb2], 0, 0, 0);
        }
    __syncthreads();
#pragma unroll
    for (int r = 0; r < 16; ++r) { const int t = 32 * tb + crow(r, hi), sc = 32 * sb + r32; const float v = (sc <= t) ? am[r] : 0.f;
        *(LAS bf16_t*)(L + HG_KT + t * 272 + sc * 2) = f2bf(v); }
    __syncthreads();
#pragma unroll
    for (int ks = 0; ks < 4; ++ks) {
        const bf16x8 vf = *(const LAS bf16x8*)(L + HG_VT + (32 * dvb + r32) * 144 + (16 * ks + 8 * hi) * 2);
#pragma unroll
        for (int tb2 = 0; tb2 < 2; ++tb2) {
            const bf16x8 af = *(const LAS bf16x8*)(L + HG_KT + (32 * tb2 + r32) * 272 + (16 * ks + 8 * hi) * 2);
            o[tb2] = __builtin_amdgcn_mfma_f32_32x32x16_bf16(af, vf, o[tb2], 0, 0, 0);
        }
    }
    float* op = opart + (size_t)d * MR * D;
#pragma unroll
    for (int tb2 = 0; tb2 < 2; ++tb2)
#pragma unroll
        for (int r = 0; r < 16; ++r) { const int i = 32 * tb2 + crow(r, hi); const int tk = d ? (T - 1 - (64 * c + i)) : (64 * c + i);
            op[(rowbase + tk) * D + h * 128 + 32 * dvb + r32] = o[tb2][r]; }
    __syncthreads();
}

#define RLX_AGENT __ATOMIC_RELAXED, __HIP_MEMORY_SCOPE_AGENT
#define XB_TMO      128
#define XB_XCNT(j)  (256  + 64 * (j))
#define XB_XSUB(j)  (1280 + 64 * (j))
#define XB_XGEN(j)  (2304 + 64 * (j))
#define XB_TOP      3328
#define XB_TOPGEN   3392
#define XCD_BAR_WORDS 3456
#define XB_SPIN_CAP (1u << 18)

__device__ __forceinline__ unsigned xb_ld(unsigned* p)              { return __hip_atomic_load(p, __ATOMIC_RELAXED, __HIP_MEMORY_SCOPE_AGENT); }
__device__ __forceinline__ unsigned xb_add(unsigned* p, unsigned v) { return __hip_atomic_fetch_add(p, v, __ATOMIC_RELAXED, __HIP_MEMORY_SCOPE_AGENT); }
__device__ __forceinline__ unsigned xb_xcc_id() { return (unsigned)__builtin_amdgcn_s_getreg((3 << 11) | 20) & 0xFu; }
#define XB_SPIN(cond, bar) do { unsigned _sp = 0; while (cond) { __builtin_amdgcn_s_sleep(1); \
    if ((++_sp & 255u) == 0u) { if (xb_ld(&(bar)[XB_TMO])) break; if (_sp > XB_SPIN_CAP) { atomicAdd(&(bar)[XB_TMO], 1u); break; } } } } while (0)

struct XcdBarrier {
    unsigned* bar; unsigned x;
    volatile LAS unsigned* st;
};

__device__ __forceinline__ XcdBarrier xcd_barrier_post(unsigned* bar, volatile LAS unsigned* st) {
    XcdBarrier b; b.bar = bar; b.x = xb_xcc_id(); b.st = st;
    if (threadIdx.x == 0) (void)xb_add(&bar[XB_XCNT(b.x)], 1u);
    return b;
}
__device__ __forceinline__ void xcd_barrier_complete(unsigned* bar, unsigned x, unsigned& nloc, unsigned& nx) {
    const unsigned G = gridDim.x * gridDim.y * gridDim.z;
    unsigned sum, cnt, mine, sp = 0u;
    for (;;) {
        sum = 0u; cnt = 0u; mine = 0u;
#pragma unroll
        for (unsigned j = 0; j < 16; ++j) { const unsigned c = xb_ld(&bar[XB_XCNT(j)]); sum += c; cnt += (c > 0u) ? 1u : 0u; mine = (j == x) ? c : mine; }
        if (sum == G) break;
        __builtin_amdgcn_s_sleep(1);
        if ((++sp & 255u) == 0u) { if (xb_ld(&bar[XB_TMO])) break; if (sp > XB_SPIN_CAP) { atomicAdd(&bar[XB_TMO], 1u); break; } }
    }
    nloc = mine > 0u ? mine : 1u; nx = cnt > 0u ? cnt : 1u;
}

__device__ __forceinline__ void xcd_barrier(const XcdBarrier& b) {
    asm volatile("s_waitcnt vmcnt(0)" ::: "memory");
    __syncthreads();
    if (threadIdx.x == 0) {
        unsigned* bar = b.bar;
        __builtin_amdgcn_s_waitcnt(0);
        unsigned nloc = b.st[0], nx = b.st[1];
        if (nloc == 0u) { xcd_barrier_complete(bar, b.x, nloc, nx); b.st[0] = nloc; b.st[1] = nx; }
        const unsigned old = xb_add(&bar[XB_XSUB(b.x)], 1u);
        const unsigned gen = old / nloc;
        if (old + 1u == (gen + 1u) * nloc) {
            __builtin_amdgcn_fence(__ATOMIC_RELEASE, "agent");
            asm volatile("s_waitcnt vmcnt(0)" ::: "memory");
            const unsigned og = xb_add(&bar[XB_TOP], 1u);
            const unsigned tg = og / nx;
            if (og + 1u == (tg + 1u) * nx) xb_add(&bar[XB_TOPGEN], 1u);
            else XB_SPIN(xb_ld(&bar[XB_TOPGEN]) == tg, bar);
            __builtin_amdgcn_fence(__ATOMIC_ACQUIRE, "agent");
            xb_add(&bar[XB_XGEN(b.x)], 1u);
            asm volatile("s_waitcnt vmcnt(0)" ::: "memory");
        } else {
            XB_SPIN(xb_ld(&bar[XB_XGEN(b.x)]) == gen, bar);
            __builtin_amdgcn_fence(__ATOMIC_ACQUIRE, "agent");
            asm volatile("s_waitcnt vmcnt(0)" ::: "memory");
        }
    }
    __syncthreads();
}


__global__ void __launch_bounds__(512) fwd_kernel(Params p) {
    extern __shared__ __attribute__((aligned(16))) unsigned char lds_raw[];
    LAS unsigned char* lds = (LAS unsigned char*)lds_raw;
    const int G = gridDim.x, bid = blockIdx.x;
    const int NGW = G * 8;
#define PHASE_IDS int tid = threadIdx.x; asm volatile("" : "+v"(tid)); const int lane = tid & 63; const int wave = __builtin_amdgcn_readfirstlane(tid >> 6); const int gw = bid * 8 + wave; (void)lane; (void)gw;
    unsigned char* ws = p.ws;
    unsigned* ctl = (unsigned*)(ws + WS_CTL);
    bf16_t* Win_t = (bf16_t*)(ws + WS_WIN); bf16_t* Wa_t = (bf16_t*)(ws + WS_WA); bf16_t* Wb_t = (bf16_t*)(ws + WS_WB); bf16_t* Wout_t = (bf16_t*)(ws + WS_WOUT);
    bf16_t* Wup_t = (bf16_t*)(ws + WS_WUP); bf16_t* Wdn_t = (bf16_t*)(ws + WS_WDN);
    bf16_t* HB = (bf16_t*)(ws + WS_HB); bf16_t* PROJ = (bf16_t*)(ws + WS_PROJ); bf16_t* U = (bf16_t*)(ws + WS_U); bf16_t* VT = (bf16_t*)(ws + WS_VT);
    bf16_t* OA = (bf16_t*)(ws + WS_OA); bf16_t* OB = (bf16_t*)(ws + WS_OB); bf16_t* MERGED = (bf16_t*)(ws + WS_MERGED); bf16_t* Y = (bf16_t*)(ws + WS_Y);
    float* OPART = (float*)(ws + WS_OPART); float* STASH = (float*)(ws + WS_STASH); bf16_t* SBUF = (bf16_t*)(ws + WS_SB); float* DEC = (float*)(ws + WS_DEC);
#if N_LAUNCH_MODE == 1
    cg::grid_group grid = cg::this_grid();
    volatile LAS unsigned* bst = (volatile LAS unsigned*)(lds + LDS_BYTES - 64);
    if (threadIdx.x == 0) { bst[0] = 0u; bst[1] = 0u; }
    __syncthreads();
    unsigned* barw = ctl + 4096;
    XcdBarrier xbar; xbar.bar = barw; xbar.x = 0; xbar.st = bst;
#define GRID_SYNC() do { if (ph == 1) { grid.sync(); xbar = xcd_barrier_post(barw, bst); } else xcd_barrier(xbar); } while (0)
#else
#define GRID_SYNC() do {} while (0)
#endif
    const int lo = p.ph_lo, hi = p.ph_hi;
    int ph = 0;
#define RUN_PHASE (ph >= lo && ph < hi)
#define END_PHASE do { ++ph; if (ph > lo && ph < hi) GRID_SYNC(); } while (0)

    if (RUN_PHASE) { PHASE_IDS
        if (bid == 0) { if (tid < 64) ctl[tid] = 0u; for (int i = tid; i < XCD_BAR_WORDS; i += 512) ctl[4096 + i] = 0u; }
        LAS float* scr = (LAS float*)(lds + wave * 16384);
        constexpr int I_IN = (D / 64) * (NPROJ / 32), I_SQ = (D / 64) * (D / 32), I_UP = (D / 64) * (FF / 32), I_DN = (FF / 64) * (D / 32);
        constexpr int NITEMS = I_IN + 3 * I_SQ + I_UP + I_DN;
        for (int it = gw; it < NITEMS; it += NGW) {
            int r = it;
            if (r < I_IN) { p0_transpose_item(p.in[I_WIN], D, NPROJ, Win_t, scr, r, lane, true); continue; } r -= I_IN;
            if (r < I_SQ) { p0_transpose_item(p.in[I_WPA], D, D, Wa_t, scr, r, lane, false); continue; } r -= I_SQ;
            if (r < I_SQ) { p0_transpose_item(p.in[I_WPB], D, D, Wb_t, scr, r, lane, false); continue; } r -= I_SQ;
            if (r < I_SQ) { p0_transpose_item(p.in[I_WOUT], D, D, Wout_t, scr, r, lane, false); continue; } r -= I_SQ;
            if (r < I_UP) { p0_transpose_item(p.in[I_WUP], D, FF, Wup_t, scr, r, lane, false); continue; } r -= I_UP;
            p0_transpose_item(p.in[I_WDN], FF, D, Wdn_t, scr, r, lane, false);
        }
        for (int m = gw; m < MR; m += NGW) row_prenorm(p.in[I_XP] + (size_t)m * D, p.in[I_GPRE], HB + (size_t)m * D, lane);
    }
    END_PHASE;

#pragma unroll 1
    for (int rnd = 0; rnd < NROUND; ++rnd) {
        const int T = rnd == 0 ? 4096 : 8192; const int nseq = MR / T;
        const float* xr = rnd == 0 ? p.in[I_XP] : p.in[I_XS] + (size_t)(rnd - 1) * MR * D;
        float* outr = p.out + (size_t)rnd * MR * D;
        if (RUN_PHASE) {
            pg8::Gemm g{HB, Win_t, MR, NPROJ, D}; pg8::StaticOrder S; S.init(MR, NPROJ, G, bid);
            pg8::Epi<1> E{PROJ, NPROJ, nullptr, 0, 0, VT, T};
            pg8::gemm_phase<pg8::Epi<1>, pg8::StaticOrder, true, true>(lds, g, S, E);
        }
        END_PHASE;
        if (RUN_PHASE) {
            const int nit = nseq * 8 * (T / 64);
            for (int it = bid; it < nit; it += G) { const int c = it % (T / 64), sh = it / (T / 64); hgrn_a_item(lds, PROJ, SBUF, DEC, p.in[I_LBF], p.in[I_LBB], sh / 8, sh % 8, c, T); }
        }
        END_PHASE;
        if (RUN_PHASE) {
            const int nit = nseq * 8 * 2 * 4;
            for (int it = bid; it < nit; it += G) hgrn_scan_item(SBUF, DEC, it >> 2, it & 3, T / 64);
        }
        END_PHASE;
        if (RUN_PHASE) { PHASE_IDS
            {
                const int nit = nseq * 8 * (T / 64);
                for (int it = bid; it < nit; it += G) { const int c = it % (T / 64), sh = it / (T / 64); hgrn_c_item(lds, PROJ, SBUF, OPART, p.in[I_LBF], p.in[I_LBB], sh / 8, sh % 8, c, T); }
            }
            float lam;
            { float a = p.in[I_LQ1][lane] * p.in[I_LK1][lane], b = p.in[I_LQ2][lane] * p.in[I_LK2][lane]; a = wave_sum(a); b = wave_sum(b); lam = expf(a) - expf(b) + 0.2f; }
            const int nqb = T / 256, nitems = nseq * 8 * nqb;
            LAS int* slot = (LAS int*)(lds + AT_TAB + 2048);
            if (G == 256) {
                const int xcd = bid & 7, j = bid >> 3;
                for (int i = 0; i < nitems / 256; ++i) {
                    const int li = i * 32 + j, sh = xcd + 8 * (li / nqb), qb = li % nqb;
                    attn_item(lds, PROJ, VT, OA, STASH, p.in[I_RELB], p.in[I_GSUB], lam, sh / 8, sh % 8, qb, T);
                }
            } else {
                for (;;) {
                    __syncthreads();
                    if (tid == 0) *slot = (int)atomicAdd(&ctl[rnd], 1u);
                    __syncthreads();
                    const int it = *slot;
                    if (it >= nitems) break;
                    const int qb = it % nqb, sh = it / nqb;
                    attn_item(lds, PROJ, VT, OA, STASH, p.in[I_RELB], p.in[I_GSUB], lam, sh / 8, sh % 8, qb, T);
                }
            }
        }
        END_PHASE;
        if (RUN_PHASE) { PHASE_IDS
            pg8::Gemm g{OA, Wa_t, MR, D, D}; pg8::StaticOrder S; S.init(MR, D, G, bid);
            pg8::Epi<2> E{MERGED, D, PROJ, NPROJ, C_GA, nullptr, 0};
            pg8::gemm_phase<pg8::Epi<2>, pg8::StaticOrder, true, true>(lds, g, S, E);
            for (int m = gw; m < MR; m += NGW)
                row_hgrn_fin(OPART + (size_t)m * D, OPART + (size_t)MR * D + (size_t)m * D, PROJ + (size_t)m * NPROJ + C_GOG, p.in[I_GHO], OB + (size_t)m * D, lane);
        }
        END_PHASE;
        if (RUN_PHASE) {
            pg8::Gemm g{OB, Wb_t, MR, D, D}; pg8::StaticOrder S; S.init(MR, D, G, bid);
            pg8::Epi<3> E{MERGED, D, PROJ, NPROJ, C_GB, nullptr, 0};
            pg8::gemm_phase<pg8::Epi<3>, pg8::StaticOrder, true, true>(lds, g, S, E);
        }
        END_PHASE;
        if (RUN_PHASE) {
            pg8::Gemm g{MERGED, Wout_t, MR, D, D}; pg8::StaticOrder S; S.init(MR, D, G, bid);
            pg8::Epi<0> E{Y, D, nullptr, 0, 0, nullptr, 0};
            pg8::gemm_phase<pg8::Epi<0>, pg8::StaticOrder, true, true>(lds, g, S, E);
        }
        END_PHASE;
        if (RUN_PHASE) { PHASE_IDS
            for (int m = gw; m < MR; m += NGW)
                row_normres1(xr + (size_t)m * D, Y + (size_t)m * D, p.in[I_GPOST], p.in[I_GMPRE], outr + (size_t)m * D, HB + (size_t)m * D, lane);
        }
        END_PHASE;
        if (RUN_PHASE) {
            pg8::Gemm g{HB, Wup_t, MR, FF, D}; pg8::StaticOrder S; S.init(MR, FF, G, bid);
            pg8::Epi<4> E{U, FF, nullptr, 0, 0, nullptr, 0};
            pg8::gemm_phase<pg8::Epi<4>, pg8::StaticOrder, true, true>(lds, g, S, E);
        }
        END_PHASE;
        if (RUN_PHASE) {
            pg8::Gemm g{U, Wdn_t, MR, D, FF}; pg8::StaticOrder S; S.init(MR, D, G, bid);
            pg8::Epi<0> E{Y, D, nullptr, 0, 0, nullptr, 0};
            pg8::gemm_phase<pg8::Epi<0>, pg8::StaticOrder, true, true>(lds, g, S, E);
        }
        END_PHASE;
        if (RUN_PHASE) { PHASE_IDS
            for (int m = gw; m < MR; m += NGW) row_final(Y + (size_t)m * D, p.in[I_GMPOST], outr + (size_t)m * D, lane);
            if (rnd + 1 < NROUND) {
                const float* xn = p.in[I_XS] + (size_t)rnd * MR * D;
                for (int m = gw; m < MR; m += NGW) row_prenorm(xn + (size_t)m * D, p.in[I_GPRE], HB + (size_t)m * D, lane);
            }
        }
        END_PHASE;
    }
}

constexpr int NPHASES = 1 + NROUND * 11;

extern "C" void kernel_launch(void* const* d_in, const int* in_sizes, int n_in, void* d_out, int out_size, void* d_ws, size_t ws_size, hipStream_t stream) {
    static int grid = 0;
    if (grid == 0) {
        if (n_in != 21 || ws_size < WS_END) { fprintf(stderr, "kernel_launch: unexpected n_in %d / ws %zu\n", n_in, ws_size); grid = -1; return; }
        int dev = 0, cus = 0, per_cu = 0;
        hipGetDevice(&dev);
        hipDeviceGetAttribute(&cus, hipDeviceAttributeMultiprocessorCount, dev);
        hipFuncSetAttribute((const void*)fwd_kernel, hipFuncAttributeMaxDynamicSharedMemorySize, LDS_BYTES);
        hipOccupancyMaxActiveBlocksPerMultiprocessor(&per_cu, (const void*)fwd_kernel, 512, LDS_BYTES);
        if (per_cu < 1) { fprintf(stderr, "kernel_launch: occupancy query says %d blocks/CU\n", per_cu); per_cu = 1; }
        (void)hipGetLastError();
        grid = cus;
    }
    if (grid < 0) return;
    Params p{};
    for (int i = 0; i < 21; ++i) p.in[i] = (const float*)d_in[i];
    p.out = (float*)d_out; p.ws = (unsigned char*)d_ws;
#if N_LAUNCH_MODE == 1
    p.ph_lo = 0; p.ph_hi = NPHASES;
    void* args[] = {&p};
    hipError_t e = hipLaunchCooperativeKernel((const void*)fwd_kernel, dim3(grid), dim3(512), args, LDS_BYTES, stream);
    if (e != hipSuccess) fprintf(stderr, "cooperative launch failed: %s (grid %d)\n", hipGetErrorString(e), grid);
#else
    for (int i = 0; i < NPHASES; ++i) { p.ph_lo = i; p.ph_hi = i + 1; hipLaunchKernelGGL(fwd_kernel, dim3(grid), dim3(512), LDS_BYTES, stream, p); }
#endif
}
```

```cpp
#include <hip/hip_runtime.h>
#include <hip/hip_cooperative_groups.h>
#include <cstdio>
#include <cstdint>
namespace cg = cooperative_groups;

#ifndef N_LAUNCH_MODE
#define N_LAUNCH_MODE 1
#endif

#define LAS __attribute__((address_space(3)))
typedef unsigned short bf16_t;
typedef short bf16x8 __attribute__((ext_vector_type(8)));
typedef float f32x4 __attribute__((ext_vector_type(4)));
typedef float f32x16 __attribute__((ext_vector_type(16)));
typedef unsigned u32x4 __attribute__((ext_vector_type(4)));
typedef unsigned u32x2 __attribute__((ext_vector_type(2)));
typedef float f32x2_t __attribute__((ext_vector_type(2)));
typedef __bf16 bf16x2_t __attribute__((ext_vector_type(2)));

constexpr int D = 1024, NPROJ = 10240, FF = 4096;
constexpr int MR = 16384;
constexpr int NROUND = 5;
constexpr float EPS = 1e-6f;
constexpr float LOG2E = 1.4426950408889634f;
constexpr float QSCALE = 0.125f * LOG2E;
constexpr int C_AQ = 0, C_AK = 1024, C_AV = 2048, C_GQ = 3072, C_GFF = 4096, C_GFB = 5120, C_GI = 6144, C_GOG = 7168, C_GA = 8192, C_GB = 9216;

constexpr size_t MiB = 1u << 20;
constexpr size_t WS_CTL = 0;
constexpr size_t WS_WIN = 1 * MiB, WS_WA = 21 * MiB, WS_WB = 23 * MiB, WS_WOUT = 25 * MiB, WS_WUP = 27 * MiB, WS_WDN = 35 * MiB;
constexpr size_t WS_HB = 44 * MiB, WS_PROJ = 76 * MiB, WS_U = WS_PROJ, WS_VT = 396 * MiB, WS_OA = 428 * MiB, WS_OB = 460 * MiB;
constexpr size_t WS_MERGED = 492 * MiB, WS_Y = 524 * MiB, WS_OPART = 556 * MiB, WS_STASH = 684 * MiB, WS_SB = 716 * MiB, WS_DEC = 844 * MiB, WS_END = 848 * MiB;

__device__ __forceinline__ float bf2f(unsigned u) { return __uint_as_float(u << 16); }
__device__ __forceinline__ unsigned cvtpk(float lo, float hi) { f32x2_t v = {lo, hi}; bf16x2_t b = __builtin_convertvector(v, bf16x2_t); return __builtin_bit_cast(unsigned, b); }
__device__ __forceinline__ bf16_t f2bf(float f) { return (bf16_t)(cvtpk(f, 0.f) & 0xffffu); }
__device__ __forceinline__ float fexp2(float x) { return __builtin_amdgcn_exp2f(x); }
__device__ __forceinline__ float flog2(float x) { return __builtin_amdgcn_logf(x); }
__device__ __forceinline__ float frcp(float x) { return __builtin_amdgcn_rcpf(x); }
__device__ __forceinline__ float sigmoidf_(float x) { return frcp(1.f + fexp2(-x * LOG2E)); }
__device__ __forceinline__ int crow(int r, int hi) { return (r & 3) + 8 * (r >> 2) + 4 * hi; }

namespace pg8 {
constexpr int BM = 256, BK = 64, HALF = 128, HTB = HALF * BK * 2, STAGE_BYTES = 8 * HTB, NXCD = 8, WGM = 8;
__host__ __device__ __forceinline__ int lds_byte(int r, int c) { const int st = (r >> 4) * 2 + (c >> 5), rr = r & 15, cc = c & 31, ob = rr * 64 + cc * 2; return st * 1024 + (ob ^ (((ob >> 9) & 1) << 5)); }
__host__ __device__ __forceinline__ void stage_rc(int b, int& R, int& C) { const int st = b / 1024, sb = b % 1024, swz = sb ^ (((sb >> 9) & 1) << 5); R = (st >> 1) * 16 + swz / 64; C = (st & 1) * 32 + (swz % 64) / 2; }
__host__ __device__ __forceinline__ int perm32(int rho) { const int n = rho >> 4, i = rho & 15; return 8 * (i >> 2) + 4 * n + (i & 3); }
struct Unit { int pm, pn; };
struct Gemm { const bf16_t* A; const bf16_t* Bt; int M, N, K; };
struct StaticOrder {
    int nM, nN, nwg, G, c;
    __host__ __device__ void init(int M, int N, int G_, int c_) { nM = M / BM; nN = N / BM; nwg = nM * nN; G = G_; c = c_; }
    __host__ __device__ bool next(int i, Unit& u) const {
        const long L = (long)i * G + c; if (L >= nwg) return false;
        int wgid = (int)L; { const int q = nwg / NXCD, r = nwg % NXCD, xcd = wgid % NXCD, off = wgid / NXCD; wgid = (xcd < r ? xcd * (q + 1) : r * (q + 1) + (xcd - r) * q) + off; }
        const int nig = WGM * nN, gid = wgid / nig, fm = gid * WGM, gsz = (nM - fm) < WGM ? (nM - fm) : WGM;
        u.pm = fm + ((wgid % nig) % gsz); u.pn = (wgid % nig) / gsz; return true;
    }
    __device__ __forceinline__ void a_ready(const Unit&) const {}
    __device__ __forceinline__ void done(const Unit&) const {}
};

template <int MODE> struct Epi {
    static constexpr bool PERM = true, AFTER_DRAIN = false;
    bf16_t* O; int ldc; const bf16_t* G; int ldg; int gcol0; bf16_t* VT; int T;
    __device__ __forceinline__ void operator()(const f32x4 (&acc)[2][2][4][2], const Unit& u, int wr, int wc, int fr, int fq) const {
        const int row0 = u.pm * BM + wr * 64 + fr; const int colt = u.pn * BM; const int col0 = colt + wc * 32 + 8 * fq;
        if (MODE == 1 && colt >= C_AV && colt < C_AV + 1024) {
            const int s = (u.pm * BM) / T, t0 = (u.pm * BM) % T;
            const int pf = (fr & 3) | ((fr & 4) << 1) | ((fr & 8) >> 1);
#pragma unroll
            for (int ai = 0; ai < 2; ++ai)
#pragma unroll
                for (int m = 0; m < 4; ++m) { const int tpos = t0 + ai * 128 + wr * 64 + m * 16 + pf;
#pragma unroll
                    for (int bj = 0; bj < 2; ++bj) { const int head = (colt - C_AV) / 128 + bj;
#pragma unroll
                        for (int n = 0; n < 2; ++n)
#pragma unroll
                            for (int j = 0; j < 4; ++j) { const int dv = wc * 32 + 8 * fq + 4 * n + j;
                                VT[((size_t)(s * 8 + head) * 128 + dv) * T + tpos] = f2bf(acc[ai][bj][m][n][j]); } } }
            return;
        }
#pragma unroll
        for (int ai = 0; ai < 2; ++ai)
#pragma unroll
            for (int m = 0; m < 4; ++m) { const size_t row = (size_t)(row0 + ai * HALF + m * 16); bf16_t* rowp = O + row * ldc + col0;
#pragma unroll
                for (int bj = 0; bj < 2; ++bj) { f32x4 v0 = acc[ai][bj][m][0], v1 = acc[ai][bj][m][1];
                    if (MODE == 2 || MODE == 3) {
                        const u32x4 gw = *(const u32x4*)(G + row * ldg + gcol0 + col0 + bj * HALF);
                        v0[0] *= sigmoidf_(bf2f(gw[0] & 0xffffu)); v0[1] *= sigmoidf_(bf2f(gw[0] >> 16)); v0[2] *= sigmoidf_(bf2f(gw[1] & 0xffffu)); v0[3] *= sigmoidf_(bf2f(gw[1] >> 16));
                        v1[0] *= sigmoidf_(bf2f(gw[2] & 0xffffu)); v1[1] *= sigmoidf_(bf2f(gw[2] >> 16)); v1[2] *= sigmoidf_(bf2f(gw[3] & 0xffffu)); v1[3] *= sigmoidf_(bf2f(gw[3] >> 16));
                    }
                    if (MODE == 3) {
                        const u32x4 ow = *(const u32x4*)(rowp + bj * HALF);
                        v0[0] += bf2f(ow[0] & 0xffffu); v0[1] += bf2f(ow[0] >> 16); v0[2] += bf2f(ow[1] & 0xffffu); v0[3] += bf2f(ow[1] >> 16);
                        v1[0] += bf2f(ow[2] & 0xffffu); v1[1] += bf2f(ow[2] >> 16); v1[2] += bf2f(ow[3] & 0xffffu); v1[3] += bf2f(ow[3] >> 16);
                    }
                    if (MODE == 4) {
#pragma unroll
                        for (int j = 0; j < 4; ++j) { float a = fmaxf(v0[j], 0.f), b = fmaxf(v1[j], 0.f); v0[j] = a * a; v1[j] = b * b; }
                    }
                    u32x4 w; w.x = cvtpk(v0[0], v0[1]); w.y = cvtpk(v0[2], v0[3]); w.z = cvtpk(v1[0], v1[1]); w.w = cvtpk(v1[2], v1[3]);
                    *(u32x4*)(rowp + bj * HALF) = w; } }
    }
};

template <class EpiT, class Sched, bool ALIGN_EPI = false, bool SP2 = false>
__device__ __forceinline__ void gemm_phase(LAS unsigned char* lds, const Gemm g, const Sched& S, const EpiT& E) {
    int tid_ = threadIdx.x; asm volatile("" : "+v"(tid_));
    const int tid = tid_, wid = __builtin_amdgcn_readfirstlane(tid >> 6), lane = tid & 63, wr = wid >> 2, wc = wid & 3, fr = lane & 15, fq = lane >> 4;
    const int K = g.K, nt = K / BK;
    unsigned voffA[2], voffB[2];
#pragma unroll
    for (int i = 0; i < 2; ++i) { int R, C; stage_rc(tid * 16 + i * 8192, R, C); const int Rb = EpiT::PERM ? ((R & ~31) + perm32(R & 31)) : R;
        voffA[i] = (unsigned)(R * K + C) * 2u; voffB[i] = (unsigned)(Rb * K + C) * 2u; }
    const size_t kstep = (size_t)(BK * 2);
    const size_t hstep = (size_t)HALF * K * 2;
    const size_t tstep = 2 * hstep;
    const unsigned ldsw = (unsigned)wid * 1024u;
    const int aoff = lds_byte(wr * 64 + fr, fq * 8), boff = lds_byte(wc * 32 + fr, fq * 8);
#define PG8_SA(b, h) (((b) * 2 + (h)) * HTB)
#define PG8_SB(b, h) ((4 + (b) * 2 + (h)) * HTB)
#define PG8_STAGE(bufoff, gbase, voff) do { _Pragma("unroll") for (int _i = 0; _i < 2; ++_i) \
        __builtin_amdgcn_global_load_lds((const unsigned*)((const char*)(gbase) + (voff)[_i]), (LAS unsigned*)(lds + (bufoff) + ldsw + _i * 8192), 16, 0, 0); } while (0)
#define PG8_LDA(dst, b, h) do { _Pragma("unroll") for (int m = 0; m < 4; ++m) _Pragma("unroll") for (int k = 0; k < 2; ++k) dst[m][k] = *(const LAS bf16x8*)(lds + PG8_SA(b, h) + aoff + m * 2048 + k * 1024); } while (0)
#define PG8_LDB(dst, b, h) do { _Pragma("unroll") for (int n = 0; n < 2; ++n) _Pragma("unroll") for (int k = 0; k < 2; ++k) dst[n][k] = *(const LAS bf16x8*)(lds + PG8_SB(b, h) + boff + n * 2048 + k * 1024); } while (0)
#define PG8_MMA(ai, bj, At, Bt) do { __builtin_amdgcn_s_setprio(1); _Pragma("unroll") for (int m = 0; m < 4; ++m) _Pragma("unroll") for (int n = 0; n < 2; ++n) _Pragma("unroll") for (int k = 0; k < 2; ++k) \
        acc[ai][bj][m][n] = __builtin_amdgcn_mfma_f32_16x16x32_bf16(Bt[n][k], At[m][k], acc[ai][bj][m][n], 0, 0, 0); __builtin_amdgcn_s_setprio(0); } while (0)
#define PG8_WAIT_V(n) asm volatile("s_waitcnt vmcnt(" #n ")" ::: "memory")
#define PG8_WAIT_L(n) asm volatile("s_waitcnt lgkmcnt(" #n ")" ::: "memory")
#define PG8_BAR __builtin_amdgcn_s_barrier()
#define PG8_SCHED __builtin_amdgcn_sched_barrier(0)
    Unit cur, nxt; int ui = 0;
    if (!S.next(0, cur)) return;
    f32x4 acc[2][2][4][2];
#pragma unroll
    for (int a = 0; a < 2; ++a)
#pragma unroll
        for (int b = 0; b < 2; ++b)
#pragma unroll
            for (int m = 0; m < 4; ++m)
#pragma unroll
                for (int n = 0; n < 2; ++n) acc[a][b][m][n] = (f32x4){0.f, 0.f, 0.f, 0.f};
    bf16x8 At[4][2], B0[2][2], B1[2][2];
    const char* cA = (const char*)g.A + (size_t)cur.pm * tstep; const char* cB = (const char*)g.Bt + (size_t)cur.pn * tstep;
    S.a_ready(cur);
    if constexpr (SP2) {
        PG8_STAGE(PG8_SB(0, 0), cB, voffB); PG8_STAGE(PG8_SB(0, 1), cB + hstep, voffB); PG8_STAGE(PG8_SA(0, 0), cA, voffA); PG8_STAGE(PG8_SA(0, 1), cA + hstep, voffA);
        if (wr == 1) PG8_BAR;
        PG8_WAIT_V(2); PG8_BAR;
        PG8_STAGE(PG8_SB(1, 0), cB + kstep, voffB); PG8_STAGE(PG8_SA(1, 0), cA + kstep, voffA); PG8_STAGE(PG8_SB(1, 1), cB + hstep + kstep, voffB);
        PG8_WAIT_V(6); PG8_BAR;
    } else {
        PG8_STAGE(PG8_SB(0, 0), cB, voffB); PG8_STAGE(PG8_SA(0, 0), cA, voffA); PG8_STAGE(PG8_SB(0, 1), cB + hstep, voffB); PG8_STAGE(PG8_SA(0, 1), cA + hstep, voffA);
        if (wr == 1) PG8_BAR;
        PG8_WAIT_V(4); PG8_BAR;
        PG8_STAGE(PG8_SB(1, 0), cB + kstep, voffB); PG8_STAGE(PG8_SA(1, 0), cA + kstep, voffA); PG8_STAGE(PG8_SB(1, 1), cB + hstep + kstep, voffB);
        PG8_WAIT_V(6); PG8_BAR;
    }
    for (;;) {
        const bool has_next = S.next(ui + 1, nxt);
        const char* nA = has_next ? (const char*)g.A + (size_t)nxt.pm * tstep : cA; const char* nB = has_next ? (const char*)g.Bt + (size_t)nxt.pn * tstep : cB;
        for (int t = 0; t < nt; t += 2) {
            const bool last = (t == nt - 2);
            const char* a1 = cA + (size_t)(t + 1) * kstep;
            const char* a2 = last ? nA : cA + (size_t)(t + 2) * kstep; const char* b2 = last ? nB : cB + (size_t)(t + 2) * kstep;
            const char* a3 = a2 + kstep; const char* b3 = b2 + kstep;
            if (last && has_next) S.a_ready(nxt);
            if constexpr (SP2) {
            PG8_LDB(B0, 0, 0); PG8_LDB(B1, 0, 1); PG8_SCHED; PG8_LDA(At, 0, 0); PG8_STAGE(PG8_SA(1, 1), a1 + hstep, voffA);
            PG8_WAIT_V(8); PG8_WAIT_L(0); PG8_BAR; PG8_MMA(0, 0, At, B0); PG8_MMA(0, 1, At, B1); PG8_BAR; PG8_SCHED;
            PG8_LDA(At, 0, 1); PG8_STAGE(PG8_SB(0, 0), b2, voffB); PG8_STAGE(PG8_SB(0, 1), b2 + hstep, voffB); PG8_STAGE(PG8_SA(0, 0), a2, voffA);
            PG8_WAIT_V(8); PG8_WAIT_L(0); PG8_BAR; PG8_MMA(1, 0, At, B0); PG8_MMA(1, 1, At, B1); PG8_BAR; PG8_SCHED;
            PG8_LDB(B0, 1, 0); PG8_LDB(B1, 1, 1); PG8_SCHED; PG8_LDA(At, 1, 0); PG8_STAGE(PG8_SA(0, 1), a2 + hstep, voffA);
            PG8_WAIT_V(8); PG8_WAIT_L(0); PG8_BAR; PG8_MMA(0, 0, At, B0); PG8_MMA(0, 1, At, B1); PG8_BAR; PG8_SCHED;
            PG8_LDA(At, 1, 1); PG8_STAGE(PG8_SB(1, 0), b3, voffB); PG8_STAGE(PG8_SB(1, 1), b3 + hstep, voffB); PG8_STAGE(PG8_SA(1, 0), a3, voffA);
            PG8_WAIT_V(8); PG8_WAIT_L(0); PG8_BAR; PG8_MMA(1, 0, At, B0); PG8_MMA(1, 1, At, B1); PG8_BAR; PG8_SCHED;
            } else {
            PG8_LDB(B0, 0, 0); PG8_SCHED; PG8_LDA(At, 0, 0); PG8_STAGE(PG8_SA(1, 1), a1 + hstep, voffA);
            PG8_WAIT_L(8); PG8_BAR; PG8_WAIT_L(0); PG8_MMA(0, 0, At, B0); PG8_BAR; PG8_SCHED;
            PG8_LDB(B1, 0, 1); PG8_STAGE(PG8_SB(0, 0), b2, voffB);
            PG8_BAR; PG8_WAIT_L(0); PG8_MMA(0, 1, At, B1); PG8_BAR;
            PG8_LDA(At, 0, 1); PG8_STAGE(PG8_SA(0, 0), a2, voffA);
            PG8_BAR; PG8_WAIT_L(0); PG8_MMA(1, 0, At, B0); PG8_BAR; PG8_SCHED;
            PG8_STAGE(PG8_SB(0, 1), b2 + hstep, voffB);
            PG8_WAIT_V(6); PG8_BAR; PG8_MMA(1, 1, At, B1); PG8_BAR;
            PG8_LDB(B0, 1, 0); PG8_SCHED; PG8_LDA(At, 1, 0); PG8_STAGE(PG8_SA(0, 1), a2 + hstep, voffA);
            PG8_WAIT_L(8); PG8_BAR; PG8_WAIT_L(0); PG8_MMA(0, 0, At, B0); PG8_BAR; PG8_SCHED;
            PG8_LDB(B1, 1, 1); PG8_STAGE(PG8_SB(1, 0), b3, voffB);
            PG8_BAR; PG8_WAIT_L(0); PG8_MMA(0, 1, At, B1); PG8_BAR;
            PG8_LDA(At, 1, 1); PG8_STAGE(PG8_SA(1, 0), a3, voffA);
            PG8_BAR; PG8_WAIT_L(0); PG8_MMA(1, 0, At, B0); PG8_BAR; PG8_SCHED;
            PG8_STAGE(PG8_SB(1, 1), b3 + hstep, voffB);
            PG8_WAIT_V(6); PG8_BAR; PG8_MMA(1, 1, At, B1); PG8_BAR;
            }
        }
        if constexpr (ALIGN_EPI) { if (wr == 0) PG8_BAR; }
        if constexpr (!EpiT::AFTER_DRAIN) { E(acc, cur, wr, wc, fr, fq); S.done(cur); }
        if (!has_next) break;
#pragma unroll
        for (int a = 0; a < 2; ++a)
#pragma unroll
            for (int b = 0; b < 2; ++b)
#pragma unroll
                for (int m = 0; m < 4; ++m)
#pragma unroll
                    for (int n = 0; n < 2; ++n) acc[a][b][m][n] = (f32x4){0.f, 0.f, 0.f, 0.f};
        cur = nxt; cA = nA; cB = nB; ++ui;
        if constexpr (ALIGN_EPI) { if (wr == 1) PG8_BAR; }
    }
    PG8_WAIT_V(0);
    if constexpr (!ALIGN_EPI) { if (wr == 0) PG8_BAR; }
    PG8_BAR;
#undef PG8_SA
#undef PG8_SB
#undef PG8_STAGE
#undef PG8_LDA
#undef PG8_LDB
#undef PG8_MMA
#undef PG8_WAIT_V
#undef PG8_WAIT_L
#undef PG8_BAR
#undef PG8_SCHED
}
}

struct Params {
    const float* in[21];
    float* out;
    unsigned char* ws;
    int ph_lo, ph_hi;
};
enum { I_XP = 0, I_XS, I_RELB, I_GPRE, I_WIN, I_LQ1, I_LK1, I_LQ2, I_LK2, I_GSUB, I_LBF, I_LBB, I_GHO, I_WPA, I_WPB, I_WOUT, I_GPOST, I_GMPRE, I_WUP, I_WDN, I_GMPOST };

constexpr int LDS_BYTES = 151552;

__device__ __forceinline__ float wave_sum(float v) {
#pragma unroll
    for (int o = 1; o < 64; o <<= 1) v += __shfl_xor(v, o);
    return v;
}
__device__ __forceinline__ float half_sum(float v) {
#pragma unroll
    for (int o = 1; o < 32; o <<= 1) v += __shfl_xor(v, o);
    return v;
}

__device__ __forceinline__ void p0_transpose_item(const float* W, int K, int N, bf16_t* WT, LAS float* scr, int item, int lane, bool scale_q) {
    const int nblk = N / 32, kb = item / nblk, nb = item % nblk, k0 = 64 * kb, n0 = 32 * nb;
    const float sc = (scale_q && n0 < 1024) ? QSCALE : 1.f;
#pragma unroll 8
    for (int i = 0; i < 32; ++i) { const int kk = 2 * i + (lane >> 5); scr[kk * 33 + (lane & 31)] = W[(size_t)(k0 + kk) * N + n0 + (lane & 31)] * sc; }
    asm volatile("s_waitcnt lgkmcnt(0)" ::: "memory");
    const int c = lane & 7;
#pragma unroll
    for (int j = 0; j < 4; ++j) { const int n = (lane >> 3) + 8 * j; const LAS float* s = scr + (8 * c) * 33 + n;
        u32x4 o; o.x = cvtpk(s[0 * 33], s[1 * 33]); o.y = cvtpk(s[2 * 33], s[3 * 33]); o.z = cvtpk(s[4 * 33], s[5 * 33]); o.w = cvtpk(s[6 * 33], s[7 * 33]);
        *(u32x4*)(WT + (size_t)(n0 + n) * K + k0 + 8 * c) = o; }
    asm volatile("s_waitcnt lgkmcnt(0)" ::: "memory");
}

__device__ __forceinline__ void row_prenorm(const float* xrow, const float* g, bf16_t* orow, int lane) {
    f32x4 v[4]; float s = 0.f;
#pragma unroll
    for (int j = 0; j < 4; ++j) { v[j] = *(const f32x4*)(xrow + 4 * lane + 256 * j); s += (v[j].x * v[j].x + v[j].y * v[j].y) + (v[j].z * v[j].z + v[j].w * v[j].w); }
    const float r = 1.f / sqrtf(wave_sum(s) * (1.f / D) + EPS);
#pragma unroll
    for (int j = 0; j < 4; ++j) { const f32x4 gg = *(const f32x4*)(g + 4 * lane + 256 * j);
        u32x2 w; w.x = cvtpk(v[j].x * r * gg.x, v[j].y * r * gg.y); w.y = cvtpk(v[j].z * r * gg.z, v[j].w * r * gg.w);
        *(u32x2*)(orow + 4 * lane + 256 * j) = w; }
}
__device__ __forceinline__ void row_normres1(const float* xrow, const bf16_t* yrow, const float* g1, const float* g2, float* outrow, bf16_t* hrow, int lane) {
    f32x4 y[4]; float s = 0.f;
#pragma unroll
    for (int j = 0; j < 4; ++j) { const u32x2 w = *(const u32x2*)(yrow + 4 * lane + 256 * j);
        y[j] = (f32x4){bf2f(w.x & 0xffffu), bf2f(w.x >> 16), bf2f(w.y & 0xffffu), bf2f(w.y >> 16)};
        s += (y[j].x * y[j].x + y[j].y * y[j].y) + (y[j].z * y[j].z + y[j].w * y[j].w); }
    const float r = 1.f / sqrtf(wave_sum(s) * (1.f / D) + EPS);
    float s2 = 0.f;
#pragma unroll
    for (int j = 0; j < 4; ++j) { const f32x4 xx = *(const f32x4*)(xrow + 4 * lane + 256 * j); const f32x4 gg = *(const f32x4*)(g1 + 4 * lane + 256 * j);
        y[j] = xx + y[j] * r * gg; *(f32x4*)(outrow + 4 * lane + 256 * j) = y[j];
        s2 += (y[j].x * y[j].x + y[j].y * y[j].y) + (y[j].z * y[j].z + y[j].w * y[j].w); }
    const float r2 = 1.f / sqrtf(wave_sum(s2) * (1.f / D) + EPS);
#pragma unroll
    for (int j = 0; j < 4; ++j) { const f32x4 gg = *(const f32x4*)(g2 + 4 * lane + 256 * j);
        u32x2 w; w.x = cvtpk(y[j].x * r2 * gg.x, y[j].y * r2 * gg.y); w.y = cvtpk(y[j].z * r2 * gg.z, y[j].w * r2 * gg.w);
        *(u32x2*)(hrow + 4 * lane + 256 * j) = w; }
}
__device__ __forceinline__ void row_final(const bf16_t* yrow, const float* g, float* outrow, int lane) {
    f32x4 y[4]; float s = 0.f;
#pragma unroll
    for (int j = 0; j < 4; ++j) { const u32x2 w = *(const u32x2*)(yrow + 4 * lane + 256 * j);
        y[j] = (f32x4){bf2f(w.x & 0xffffu), bf2f(w.x >> 16), bf2f(w.y & 0xffffu), bf2f(w.y >> 16)};
        s += (y[j].x * y[j].x + y[j].y * y[j].y) + (y[j].z * y[j].z + y[j].w * y[j].w); }
    const float r = 1.f / sqrtf(wave_sum(s) * (1.f / D) + EPS);
#pragma unroll
    for (int j = 0; j < 4; ++j) { const f32x4 xx = *(const f32x4*)(outrow + 4 * lane + 256 * j); const f32x4 gg = *(const f32x4*)(g + 4 * lane + 256 * j);
        *(f32x4*)(outrow + 4 * lane + 256 * j) = xx + y[j] * r * gg; }
}
__device__ __forceinline__ void row_hgrn_fin(const bf16_t* of, const bf16_t* ob, const bf16_t* ogrow, const float* gout, bf16_t* orow, int lane) {
#pragma unroll
    for (int j = 0; j < 4; ++j) {
        const int col = 4 * lane + 256 * j;
        const u32x2 wf = *(const u32x2*)(of + col), wb = *(const u32x2*)(ob + col);
        f32x4 v = (f32x4){bf2f(wf.x & 0xffffu) + bf2f(wb.x & 0xffffu), bf2f(wf.x >> 16) + bf2f(wb.x >> 16), bf2f(wf.y & 0xffffu) + bf2f(wb.y & 0xffffu), bf2f(wf.y >> 16) + bf2f(wb.y >> 16)};
        const float ss = half_sum((v.x * v.x + v.y * v.y) + (v.z * v.z + v.w * v.w));
        const float r = 1.f / sqrtf(ss * (1.f / 128.f) + EPS);
        const f32x4 gg = *(const f32x4*)(gout + (col & 127));
        const u32x2 w = *(const u32x2*)(ogrow + col);
        const float g0 = bf2f(w.x & 0xffffu), g1 = bf2f(w.x >> 16), g2 = bf2f(w.y & 0xffffu), g3 = bf2f(w.y >> 16);
        u32x2 o; o.x = cvtpk(v.x * r * gg.x * g0 * sigmoidf_(g0), v.y * r * gg.y * g1 * sigmoidf_(g1));
        o.y = cvtpk(v.z * r * gg.z * g2 * sigmoidf_(g2), v.w * r * gg.w * g3 * sigmoidf_(g3));
        *(u32x2*)(orow + col) = o;
    }
}

constexpr int AT_K0 = 0, AT_V0 = 24576, AT_TAB = 73728;
__device__ __forceinline__ int t5_bucket_dev(int rel) {
    const int n = rel < 0 ? -rel : rel; const int ret = rel > 0 ? 16 : 0;
    int b;
    if (n < 8) b = n; else if (n < 12) b = 8; else if (n < 16) b = 9; else if (n < 23) b = 10; else if (n < 32) b = 11; else if (n < 46) b = 12; else if (n < 64) b = 13; else if (n < 91) b = 14; else b = 15;
    return ret + b;
}
__device__ __forceinline__ void attn_item(LAS unsigned char* lds, const bf16_t* proj, const bf16_t* vT, bf16_t* oa, float* stash, const float* relb, const float* gsub, float lam,
                                          int s, int h, int qb, int T) {
    int tid_ = threadIdx.x; asm volatile("" : "+v"(tid_));
    const int tid = tid_, lane = tid & 63, r32 = lane & 31, hi = lane >> 5; const int wid = __builtin_amdgcn_readfirstlane(tid >> 6);
    const int NT = T / 64;
    const size_t rowbase = (size_t)s * T;
    LAS float* tab = (LAS float*)(lds + AT_TAB);
    __syncthreads();
    for (int i = tid; i < 257; i += 512) tab[i] = relb[t5_bucket_dev(i - 128) * 8 + h] * LOG2E;
    const float EL = fexp2(relb[15 * 8 + h] * LOG2E), ERi = fexp2(-relb[31 * 8 + h] * LOG2E);
    const int qlo = qb * 256 + wid * 32;
    const size_t qrow = rowbase + qlo + r32;
    const int drow = lane >> 3, dchunk = (lane & 7) ^ drow;
    const bf16_t* vsrc[2];
#pragma unroll
    for (int i = 0; i < 2; ++i) vsrc[i] = vT + ((size_t)(s * 8 + h) * 128 + 64 * i + 8 * wid + drow) * T + dchunk * 8;
    int fo[4];
#pragma unroll
    for (int i = 0; i < 4; ++i) fo[i] = r32 * 128 + (((2 * i + hi) ^ (r32 & 7)) << 4);
#define GLDS(gp, off) __builtin_amdgcn_global_load_lds((const unsigned*)(gp), (LAS unsigned*)(lds + (off)), 16, 0, 0)
#define WAITBAR(N) asm volatile("s_waitcnt vmcnt(" #N ") lgkmcnt(0)\n\ts_barrier" ::: "memory")
    float* st = stash + ((size_t)blockIdx.x * 512 + tid) * 64;
#define TCLS(t) (((t) * 64 + 63 - qlo <= -128) ? 0 : (((t) * 64 - (qlo + 31) >= 128) ? 2 : 1))
#pragma unroll 1
    for (int c = 0; c < 2; ++c) {
        bf16x8 qr[4];
#pragma unroll
        for (int d0 = 0; d0 < 4; ++d0) qr[d0] = *(const bf16x8*)(proj + qrow * NPROJ + C_AQ + h * 128 + c * 64 + 16 * d0 + 8 * hi);
        const bf16_t* ksrc = proj + (rowbase + 8 * wid + drow) * NPROJ + C_AK + h * 128 + c * 64 + dchunk * 8;
        f32x16 o[4];
#pragma unroll
        for (int i = 0; i < 4; ++i)
#pragma unroll
            for (int r = 0; r < 16; ++r) o[i][r] = 0.f;
        float l = 0.f;
        __syncthreads();
        {
            GLDS(ksrc, AT_K0 + wid * 1024); GLDS(ksrc + (size_t)64 * NPROJ, AT_K0 + 8192 + wid * 1024);
            GLDS(vsrc[0], AT_V0 + wid * 1024); GLDS(vsrc[1], AT_V0 + (wid + 8) * 1024);
            GLDS(vsrc[0], AT_V0 + 2 * 16384 + wid * 1024); GLDS(vsrc[1], AT_V0 + 2 * 16384 + (wid + 8) * 1024);
        }
        WAITBAR(0);
        u32x4 pwp[4];
#pragma unroll
        for (int i = 0; i < 4; ++i) pwp[i] = (u32x4){0u, 0u, 0u, 0u};
        int cls_m1 = TCLS(0), cls_m2 = cls_m1;
        int s0 = 0, s1 = 1, s2 = 2;
#define SB0() __builtin_amdgcn_sched_barrier(0)
#pragma unroll 1
        for (int kt = 0; kt < NT; ++kt) {
            {
                const int ktk = min(kt + 2, NT - 1), ktv = min(kt + 1, NT - 1);
                GLDS(ksrc + (size_t)ktk * 64 * NPROJ, AT_K0 + s2 * 8192 + wid * 1024);
                GLDS(vsrc[0] + ktv * 64, AT_V0 + s1 * 16384 + wid * 1024); GLDS(vsrc[1] + ktv * 64, AT_V0 + s1 * 16384 + (wid + 8) * 1024);
            }
            const int cls = TCLS(kt);
            if (cls != cls_m1) { l *= (cls_m1 == 0) ? EL : ERi; }
            if (cls_m1 != cls_m2) { const float f = (cls_m2 == 0) ? EL : ERi;
#pragma unroll
                for (int i = 0; i < 4; ++i)
#pragma unroll
                    for (int r = 0; r < 16; ++r) o[i][r] *= f; }
            cls_m2 = cls_m1; cls_m1 = cls;
            const LAS unsigned char* Kb = lds + AT_K0 + s0 * 8192; const LAS unsigned char* Vb = lds + AT_V0 + s2 * 16384;
            bf16x8 vf[2][4];
#pragma unroll
            for (int dvb = 0; dvb < 4; ++dvb) vf[0][dvb] = *(const LAS bf16x8*)(Vb + dvb * 4096 + fo[0]);
            f32x16 pc0, pc1;
#pragma unroll
            for (int r = 0; r < 16; ++r) { pc0[r] = 0.f; pc1[r] = 0.f; }
            {
                bf16x8 ka[4][2];
#pragma unroll
                for (int d0 = 0; d0 < 4; ++d0) { ka[d0][0] = *(const LAS bf16x8*)(Kb + fo[d0]); ka[d0][1] = *(const LAS bf16x8*)(Kb + 4096 + fo[d0]); }
#pragma unroll
                for (int d0 = 0; d0 < 4; ++d0) {
                    pc0 = __builtin_amdgcn_mfma_f32_32x32x16_bf16(ka[d0][0], qr[d0], pc0, 0, 0, 0);
                    pc1 = __builtin_amdgcn_mfma_f32_32x32x16_bf16(ka[d0][1], qr[d0], pc1, 0, 0, 0);
                }
            }
            if (cls == 1) {
                const int qpos = qlo + r32, k0 = kt * 64;
#pragma unroll
                for (int r = 0; r < 16; ++r) {
                    const int rel0 = k0 + crow(r, hi) - qpos, rel1 = rel0 + 32;
                    const int i0 = min(max(rel0, -128), 128) + 128, i1 = min(max(rel1, -128), 128) + 128;
                    pc0[r] += tab[i0]; pc1[r] += tab[i1];
                }
            }
            SB0();
#pragma unroll
            for (int ks = 0; ks < 4; ++ks) {
                if (ks < 3) {
#pragma unroll
                    for (int dvb = 0; dvb < 4; ++dvb) vf[(ks + 1) & 1][dvb] = *(const LAS bf16x8*)(Vb + dvb * 4096 + fo[ks + 1]);
                }
#pragma unroll
                for (int dvb = 0; dvb < 4; ++dvb) {
                    o[dvb] = __builtin_amdgcn_mfma_f32_32x32x16_bf16(vf[ks & 1][dvb], __builtin_bit_cast(bf16x8, pwp[ks]), o[dvb], 0, 0, 0);
                    const int g = ks * 4 + dvb;
                    if (g < 8) { pc0[2 * g] = fexp2(pc0[2 * g]); pc0[2 * g + 1] = fexp2(pc0[2 * g + 1]); }
                    else { pc1[2 * g - 16] = fexp2(pc1[2 * g - 16]); pc1[2 * g - 15] = fexp2(pc1[2 * g - 15]); }
                    SB0();
                }
            }
            float sa = 0.f, sb = 0.f;
#pragma unroll
            for (int r = 0; r < 16; ++r) { sa += pc0[r]; sb += pc1[r]; }
            l += sa + sb;
#pragma unroll
            for (int i = 0; i < 4; ++i) { pwp[0][i] = cvtpk(pc0[2 * i], pc0[2 * i + 1]); pwp[1][i] = cvtpk(pc0[8 + 2 * i], pc0[8 + 2 * i + 1]);
                                          pwp[2][i] = cvtpk(pc1[2 * i], pc1[2 * i + 1]); pwp[3][i] = cvtpk(pc1[8 + 2 * i], pc1[8 + 2 * i + 1]); }
            WAITBAR(3);
            { const int t_ = s0; s0 = s1; s1 = s2; s2 = t_; }
        }
        {
            if (cls_m1 != cls_m2) { const float f = (cls_m2 == 0) ? EL : ERi;
#pragma unroll
                for (int i = 0; i < 4; ++i)
#pragma unroll
                    for (int r = 0; r < 16; ++r) o[i][r] *= f; }
            asm volatile("s_waitcnt vmcnt(0)" ::: "memory");
            const LAS unsigned char* Vb = lds + AT_V0 + s2 * 16384;
#pragma unroll
            for (int ks = 0; ks < 4; ++ks)
#pragma unroll
                for (int dvb = 0; dvb < 4; ++dvb) {
                    const bf16x8 vf = *(const LAS bf16x8*)(Vb + dvb * 4096 + fo[ks]);
                    o[dvb] = __builtin_amdgcn_mfma_f32_32x32x16_bf16(vf, __builtin_bit_cast(bf16x8, pwp[ks]), o[dvb], 0, 0, 0);
                }
        }
#undef SB0
        l += __shfl_xor(l, 32);
        const float rl = 1.f / l;
        if (c == 0) {
#pragma unroll
            for (int i = 0; i < 4; ++i)
#pragma unroll
                for (int g = 0; g < 4; ++g) *(f32x4*)(st + i * 16 + 4 * g) = (f32x4){o[i][4 * g] * rl, o[i][4 * g + 1] * rl, o[i][4 * g + 2] * rl, o[i][4 * g + 3] * rl};
        } else {
            float ss = 0.f;
#pragma unroll
            for (int i = 0; i < 4; ++i)
#pragma unroll
                for (int g = 0; g < 4; ++g) { const f32x4 s0 = *(const f32x4*)(st + i * 16 + 4 * g);
#pragma unroll
                    for (int j = 0; j < 4; ++j) { const float v = s0[j] - lam * (o[i][4 * g + j] * rl); o[i][4 * g + j] = v; ss += v * v; } }
            ss += __shfl_xor(ss, 32);
            const float rn = 0.8f / sqrtf(ss * (1.f / 128.f) + EPS);
            bf16_t* orow = oa + qrow * D + h * 128;
#pragma unroll
            for (int i = 0; i < 4; ++i)
#pragma unroll
                for (int g = 0; g < 4; ++g) { const int dv = 32 * i + 8 * g + 4 * hi; const f32x4 gg = *(const f32x4*)(gsub + dv);
                    u32x2 w; w.x = cvtpk(o[i][4 * g] * rn * gg.x, o[i][4 * g + 1] * rn * gg.y); w.y = cvtpk(o[i][4 * g + 2] * rn * gg.z, o[i][4 * g + 3] * rn * gg.w);
                    *(u32x2*)(orow + dv) = w; }
        }
    }
#undef TCLS
#undef GLDS
#undef WAITBAR
}

constexpr int HG_QT = 0, HG_KT = 17408, HG_QH = 34816, HG_VT = 52224, HG_DIR = 70656;
constexpr int HG_HS = 2 * HG_DIR;
static_assert(HG_HS + 2048 <= LDS_BYTES, "HGRN LDS map");
struct HgIds { int tid, lane, r32, hi, wid, d, k, half, wq; };
__device__ __forceinline__ HgIds hg_ids() {
    int tid_ = threadIdx.x; asm volatile("" : "+v"(tid_));
    HgIds I; I.tid = tid_; I.lane = tid_ & 63; I.r32 = I.lane & 31; I.hi = I.lane >> 5; I.wid = __builtin_amdgcn_readfirstlane(tid_ >> 6);
    I.d = tid_ >> 8; I.k = tid_ & 127; I.half = (tid_ >> 7) & 1; I.wq = I.wid & 3; return I;
}
__device__ __forceinline__ void hgrn_a_item(LAS unsigned char* lds, const bf16_t* proj, bf16_t* SB, float* DEC, const float* lbfw, const float* lbbw, int s, int h, int c, int T) {
    const HgIds I = hg_ids(); const int d = I.d, k = I.k, half = I.half, r32 = I.r32, hi = I.hi;
    LAS unsigned char* L = lds + d * HG_DIR; LAS float* hs = (LAS float*)(lds + HG_HS);
    const float* lbw = d ? lbbw : lbfw;
    const float lb = sigmoidf_(lbw[h * 128 + k] - lbw[1024 + h * 128 + k]), omlb = 1.f - lb;
    const size_t rowbase = (size_t)s * T; const int NC = T / 64;
    const int zcol = (d ? C_GFB : C_GFF) + h * 128 + k, vcol = C_GI + h * 128 + k;
    float g2[32], kk[32]; float run = 0.f;
    {
        unsigned zr[32], vr[32];
#pragma unroll
        for (int ii = 0; ii < 32; ++ii) { const int i = 32 * half + ii; const int tk = d ? (T - 1 - (64 * c + i)) : (64 * c + i); const bf16_t* rp = proj + (rowbase + tk) * NPROJ;
            zr[ii] = rp[zcol]; vr[ii] = rp[vcol]; }
#pragma unroll
        for (int q4 = 0; q4 < 4; ++q4) { u32x4 w;
#pragma unroll
            for (int e = 0; e < 4; ++e) w[e] = vr[8 * q4 + 2 * e] | (vr[8 * q4 + 2 * e + 1] << 16);
            *(LAS u32x4*)(L + HG_VT + k * 144 + (32 * half + 8 * q4) * 2) = w; }
#pragma unroll
        for (int ii = 0; ii < 32; ++ii) { const float sg = sigmoidf_(bf2f(zr[ii])); const float f = lb + omlb * sg;
            kk[ii] = omlb * (1.f - sg); run += flog2(f); g2[ii] = run; }
    }
    hs[(d * 2 + half) * 128 + k] = run;
    __syncthreads();
    const float h0 = hs[(d * 2 + 0) * 128 + k], blast = h0 + hs[(d * 2 + 1) * 128 + k];
    const float boff = half ? h0 : 0.f;
    const size_t slot = ((size_t)((s * 8 + h) * 2 + d)) * NC + c;
    if (half == 0) DEC[slot * 128 + k] = fexp2(blast);
    {
        unsigned ktt[32];
#pragma unroll
        for (int ii = 0; ii < 32; ++ii) ktt[ii] = f2bf(kk[ii] * fexp2(blast - (g2[ii] + boff)));
#pragma unroll
        for (int q4 = 0; q4 < 4; ++q4) { u32x4 w;
#pragma unroll
            for (int e = 0; e < 4; ++e) w[e] = ktt[8 * q4 + 2 * e] | (ktt[8 * q4 + 2 * e + 1] << 16);
            *(LAS u32x4*)(L + HG_QT + k * 144 + (32 * half + 8 * q4) * 2) = w; }
    }
    __syncthreads();
    f32x16 acc[4];
#pragma unroll
    for (int i = 0; i < 4; ++i)
#pragma unroll
        for (int r = 0; r < 16; ++r) acc[i][r] = 0.f;
#pragma unroll
    for (int ks = 0; ks < 4; ++ks) {
        const bf16x8 vf = *(const LAS bf16x8*)(L + HG_VT + (32 * I.wq + r32) * 144 + (16 * ks + 8 * hi) * 2);
#pragma unroll
        for (int kb = 0; kb < 4; ++kb) {
            const bf16x8 kf = *(const LAS bf16x8*)(L + HG_QT + (32 * kb + r32) * 144 + (16 * ks + 8 * hi) * 2);
            acc[kb] = __builtin_amdgcn_mfma_f32_32x32x16_bf16(vf, kf, acc[kb], 0, 0, 0);
        }
    }
    bf16_t* sp = SB + slot * 16384;
#pragma unroll
    for (int kb = 0; kb < 4; ++kb)
#pragma unroll
        for (int r = 0; r < 16; ++r) sp[(32 * I.wq + crow(r, hi)) * 128 + 32 * kb + r32] = f2bf(acc[kb][r]);
    __syncthreads();
}
__device__ __forceinline__ void hgrn_scan_item(bf16_t* SB, const float* DEC, int chain, int part, int NC) {
    int tid_ = threadIdx.x; asm volatile("" : "+v"(tid_));
    const int e = part * 512 + tid_, dv = e >> 5, k4 = (e & 31) * 4;
    bf16_t* sp = SB + (size_t)chain * NC * 16384 + dv * 128 + k4; const float* dp = DEC + (size_t)chain * NC * 128 + k4;
    float st[4];
#pragma unroll
    for (int j = 0; j < 4; ++j) st[j] = 0.f;
#pragma unroll 1
    for (int c0 = 0; c0 < NC; c0 += 8) {
        u32x2 w[8]; f32x4 dd[8];
#pragma unroll
        for (int j = 0; j < 8; ++j) { w[j] = *(const u32x2*)(sp + (size_t)(c0 + j) * 16384); dd[j] = *(const f32x4*)(dp + (size_t)(c0 + j) * 128); }
#pragma unroll
        for (int j = 0; j < 8; ++j) {
            u32x2 o; o.x = cvtpk(st[0], st[1]); o.y = cvtpk(st[2], st[3]);
            *(u32x2*)(sp + (size_t)(c0 + j) * 16384) = o;
            st[0] = dd[j].x * st[0] + bf2f(w[j].x & 0xffffu); st[1] = dd[j].y * st[1] + bf2f(w[j].x >> 16);
            st[2] = dd[j].z * st[2] + bf2f(w[j].y & 0xffffu); st[3] = dd[j].w * st[3] + bf2f(w[j].y >> 16);
        }
    }
}
__device__ __forceinline__ void hgrn_c_item(LAS unsigned char* lds, const bf16_t* proj, const bf16_t* SB, bf16_t* opart, const float* lbfw, const float* lbbw, int s, int h, int c, int T) {
    const HgIds I = hg_ids(); const int d = I.d, k = I.k, half = I.half, r32 = I.r32, hi = I.hi, dvb = I.wq;
    LAS unsigned char* L = lds + d * HG_DIR; LAS float* hs = (LAS float*)(lds + HG_HS);
    const float* lbw = d ? lbbw : lbfw;
    const float lb = sigmoidf_(lbw[h * 128 + k] - lbw[1024 + h * 128 + k]), omlb = 1.f - lb;
    const size_t rowbase = (size_t)s * T; const int NC = T / 64;
    const int zcol = (d ? C_GFB : C_GFF) + h * 128 + k, qcol = C_GQ + h * 128 + k, vcol = C_GI + h * 128 + k;
    const size_t slot = ((size_t)((s * 8 + h) * 2 + d)) * NC + c;
    bf16x8 sf[8];
    { const bf16_t* sp = SB + slot * 16384 + (32 * dvb + r32) * 128 + 8 * hi;
#pragma unroll
      for (int ks = 0; ks < 8; ++ks) sf[ks] = *(const bf16x8*)(sp + 16 * ks); }
    float g2[32], kk[32]; unsigned qv[32]; float run = 0.f;
    {
        unsigned zr[32], vr[32];
#pragma unroll
        for (int ii = 0; ii < 32; ++ii) { const int i = 32 * half + ii; const int tk = d ? (T - 1 - (64 * c + i)) : (64 * c + i); const bf16_t* rp = proj + (rowbase + tk) * NPROJ;
            zr[ii] = rp[zcol]; qv[ii] = rp[qcol]; vr[ii] = rp[vcol]; }
#pragma unroll
        for (int q4 = 0; q4 < 4; ++q4) { u32x4 w;
#pragma unroll
            for (int e = 0; e < 4; ++e) w[e] = vr[8 * q4 + 2 * e] | (vr[8 * q4 + 2 * e + 1] << 16);
            *(LAS u32x4*)(L + HG_VT + k * 144 + (32 * half + 8 * q4) * 2) = w; }
#pragma unroll
        for (int ii = 0; ii < 32; ++ii) { const float sg = sigmoidf_(bf2f(zr[ii])); const float f = lb + omlb * sg;
            kk[ii] = omlb * (1.f - sg); run += flog2(f); g2[ii] = run; }
    }
    hs[(d * 2 + half) * 128 + k] = run;
    __syncthreads();
    const float cref = hs[(d * 2 + 0) * 128 + k];
    const float boff = half ? cref : 0.f;
#pragma unroll
    for (int ii = 0; ii < 32; ++ii) { const int i = 32 * half + ii; const float b = g2[ii] + boff, bb = b - cref;
        const float e1 = fexp2(fminf(bb, 100.f)), e2 = fexp2(fminf(-bb, 100.f)); const float qf = bf2f(qv[ii]);
        *(LAS bf16_t*)(L + HG_QT + i * 272 + k * 2) = f2bf(qf * e1); *(LAS bf16_t*)(L + HG_KT + i * 272 + k * 2) = f2bf(kk[ii] * e2);
        *(LAS bf16_t*)(L + HG_QH + i * 272 + k * 2) = f2bf(qf * fexp2(b)); }
    __syncthreads();
    f32x16 am;
#pragma unroll
    for (int r = 0; r < 16; ++r) am[r] = 0.f;
    const int tb = (dvb == 0 || dvb == 3) ? 0 : 1, sb = (dvb >= 2) ? 1 : 0;
    if (dvb < 3) {
#pragma unroll
        for (int ks = 0; ks < 8; ++ks) {
            const bf16x8 a = *(const LAS bf16x8*)(L + HG_QT + (32 * tb + r32) * 272 + (16 * ks + 8 * hi) * 2);
            const bf16x8 b = *(const LAS bf16x8*)(L + HG_KT + (32 * sb + r32) * 272 + (16 * ks + 8 * hi) * 2);
            am = __builtin_amdgcn_mfma_f32_32x32x16_bf16(a, b, am, 0, 0, 0);
        }
    }
    f32x16 o[2];
#pragma unroll
    for (int i = 0; i < 2; ++i)
#pragma unroll
        for (int r = 0; r < 16; ++r) o[i][r] = 0.f;
#pragma unroll
    for (int ks = 0; ks < 8; ++ks)
#pragma unroll
        for (int tb2 = 0; tb2 < 2; ++tb2) {
            const bf16x8 af = *(const LAS bf16x8*)(L + HG_QH + (32 * tb2 + r32) * 272 + (16 * ks + 8 * hi) * 2);
            o[tb2] = __builtin_amdgcn_mfma_f32_32x32x16_bf16(af, sf[ks], o[tb2], 0, 0, 0);
        }
    __syncthreads();
#pragma unroll
    for (int r = 0; r < 16; ++r) { const int t = 32 * tb + crow(r, hi), sc = 32 * sb + r32; const float v = (sc <= t) ? am[r] : 0.f;
        *(LAS bf16_t*)(L + HG_KT + t * 272 + sc * 2) = f2bf(v); }
    __syncthreads();
#pragma unroll
    for (int ks = 0; ks < 4; ++ks) {
        const bf16x8 vf = *(const LAS bf16x8*)(L + HG_VT + (32 * dvb + r32) * 144 + (16 * ks + 8 * hi) * 2);
#pragma unroll
        for (int tb2 = 0; tb2 < 2; ++tb2) {
            const bf16x8 af = *(const LAS bf16x8*)(L + HG_KT + (32 * tb2 + r32) * 272 + (16 * ks + 8 * hi) * 2);
            o[tb2] = __builtin_amdgcn_mfma_f32_32x32x16_bf16(af, vf, o[tb2], 0, 0, 0);
        }
    }
    bf16_t* op = opart + (size_t)d * MR * D;
#pragma unroll
    for (int tb2 = 0; tb2 < 2; ++tb2)
#pragma unroll
        for (int r = 0; r < 16; ++r) { const int i = 32 * tb2 + crow(r, hi); const int tk = d ? (T - 1 - (64 * c + i)) : (64 * c + i);
            op[(rowbase + tk) * D + h * 128 + 32 * dvb + r32] = f2bf(o[tb2][r]); }
    __syncthreads();
}

#define RLX_AGENT __ATOMIC_RELAXED, __HIP_MEMORY_SCOPE_AGENT
#define XB_TMO      128
#define XB_XCNT(j)  (256  + 64 * (j))
#define XB_XSUB(j)  (1280 + 64 * (j))
#define XB_XGEN(j)  (2304 + 64 * (j))
#define XB_TOP      3328
#define XB_TOPGEN   3392
#define XCD_BAR_WORDS 3456
#define XB_SPIN_CAP (1u << 18)

__device__ __forceinline__ unsigned xb_ld(unsigned* p)              { return __hip_atomic_load(p, __ATOMIC_RELAXED, __HIP_MEMORY_SCOPE_AGENT); }
__device__ __forceinline__ unsigned xb_add(unsigned* p, unsigned v) { return __hip_atomic_fetch_add(p, v, __ATOMIC_RELAXED, __HIP_MEMORY_SCOPE_AGENT); }
__device__ __forceinline__ unsigned xb_xcc_id() { return (unsigned)__builtin_amdgcn_s_getreg((3 << 11) | 20) & 0xFu; }
#define XB_SPIN(cond, bar) do { unsigned _sp = 0; while (cond) { __builtin_amdgcn_s_sleep(1); \
    if ((++_sp & 255u) == 0u) { if (xb_ld(&(bar)[XB_TMO])) break; if (_sp > XB_SPIN_CAP) { atomicAdd(&(bar)[XB_TMO], 1u); break; } } } } while (0)

struct XcdBarrier {
    unsigned* bar; unsigned x;
    volatile LAS unsigned* st;
};

__device__ __forceinline__ XcdBarrier xcd_barrier_post(unsigned* bar, volatile LAS unsigned* st) {
    XcdBarrier b; b.bar = bar; b.x = xb_xcc_id(); b.st = st;
    if (threadIdx.x == 0) (void)xb_add(&bar[XB_XCNT(b.x)], 1u);
    return b;
}
__device__ __forceinline__ void xcd_barrier_complete(unsigned* bar, unsigned x, unsigned& nloc, unsigned& nx) {
    const unsigned G = gridDim.x * gridDim.y * gridDim.z;
    unsigned sum, cnt, mine, sp = 0u;
    for (;;) {
        sum = 0u; cnt = 0u; mine = 0u;
#pragma unroll
        for (unsigned j = 0; j < 16; ++j) { const unsigned c = xb_ld(&bar[XB_XCNT(j)]); sum += c; cnt += (c > 0u) ? 1u : 0u; mine = (j == x) ? c : mine; }
        if (sum == G) break;
        __builtin_amdgcn_s_sleep(1);
        if ((++sp & 255u) == 0u) { if (xb_ld(&bar[XB_TMO])) break; if (sp > XB_SPIN_CAP) { atomicAdd(&bar[XB_TMO], 1u); break; } }
    }
    nloc = mine > 0u ? mine : 1u; nx = cnt > 0u ? cnt : 1u;
}

__device__ __forceinline__ void xcd_barrier(const XcdBarrier& b) {
    asm volatile("s_waitcnt vmcnt(0)" ::: "memory");
    __syncthreads();
    if (threadIdx.x == 0) {
        unsigned* bar = b.bar;
        __builtin_amdgcn_s_waitcnt(0);
        unsigned nloc = b.st[0], nx = b.st[1];
        if (nloc == 0u) { xcd_barrier_complete(bar, b.x, nloc, nx); b.st[0] = nloc; b.st[1] = nx; }
        const unsigned old = xb_add(&bar[XB_XSUB(b.x)], 1u);
        const unsigned gen = old / nloc;
        if (old + 1u == (gen + 1u) * nloc) {
            __builtin_amdgcn_fence(__ATOMIC_RELEASE, "agent");
            asm volatile("s_waitcnt vmcnt(0)" ::: "memory");
            const unsigned og = xb_add(&bar[XB_TOP], 1u);
            const unsigned tg = og / nx;
            if (og + 1u == (tg + 1u) * nx) xb_add(&bar[XB_TOPGEN], 1u);
            else XB_SPIN(xb_ld(&bar[XB_TOPGEN]) == tg, bar);
            __builtin_amdgcn_fence(__ATOMIC_ACQUIRE, "agent");
            xb_add(&bar[XB_XGEN(b.x)], 1u);
            asm volatile("s_waitcnt vmcnt(0)" ::: "memory");
        } else {
            XB_SPIN(xb_ld(&bar[XB_XGEN(b.x)]) == gen, bar);
            __builtin_amdgcn_fence(__ATOMIC_ACQUIRE, "agent");
            asm volatile("s_waitcnt vmcnt(0)" ::: "memory");
        }
    }
    __syncthreads();
}


__global__ void __launch_bounds__(512) fwd_kernel(Params p) {
    extern __shared__ __attribute__((aligned(16))) unsigned char lds_raw[];
    LAS unsigned char* lds = (LAS unsigned char*)lds_raw;
    const int G = gridDim.x, bid = blockIdx.x;
    const int NGW = G * 8;
#define PHASE_IDS int tid = threadIdx.x; asm volatile("" : "+v"(tid)); const int lane = tid & 63; const int wave = __builtin_amdgcn_readfirstlane(tid >> 6); const int gw = bid * 8 + wave; (void)lane; (void)gw;
    unsigned char* ws = p.ws;
    unsigned* ctl = (unsigned*)(ws + WS_CTL);
    bf16_t* Win_t = (bf16_t*)(ws + WS_WIN); bf16_t* Wa_t = (bf16_t*)(ws + WS_WA); bf16_t* Wb_t = (bf16_t*)(ws + WS_WB); bf16_t* Wout_t = (bf16_t*)(ws + WS_WOUT);
    bf16_t* Wup_t = (bf16_t*)(ws + WS_WUP); bf16_t* Wdn_t = (bf16_t*)(ws + WS_WDN);
    bf16_t* HB = (bf16_t*)(ws + WS_HB); bf16_t* PROJ = (bf16_t*)(ws + WS_PROJ); bf16_t* U = (bf16_t*)(ws + WS_U); bf16_t* VT = (bf16_t*)(ws + WS_VT);
    bf16_t* OA = (bf16_t*)(ws + WS_OA); bf16_t* OB = (bf16_t*)(ws + WS_OB); bf16_t* MERGED = (bf16_t*)(ws + WS_MERGED); bf16_t* Y = (bf16_t*)(ws + WS_Y);
    bf16_t* OPART = (bf16_t*)(ws + WS_OPART); float* STASH = (float*)(ws + WS_STASH); bf16_t* SBUF = (bf16_t*)(ws + WS_SB); float* DEC = (float*)(ws + WS_DEC);
#if N_LAUNCH_MODE == 1
    cg::grid_group grid = cg::this_grid();
    volatile LAS unsigned* bst = (volatile LAS unsigned*)(lds + LDS_BYTES - 64);
    if (threadIdx.x == 0) { bst[0] = 0u; bst[1] = 0u; }
    __syncthreads();
    unsigned* barw = ctl + 4096;
    XcdBarrier xbar; xbar.bar = barw; xbar.x = 0; xbar.st = bst;
#define GRID_SYNC() do { if (ph == 1) { grid.sync(); xbar = xcd_barrier_post(barw, bst); } else xcd_barrier(xbar); } while (0)
#else
#define GRID_SYNC() do {} while (0)
#endif
    const int lo = p.ph_lo, hi = p.ph_hi;
    int ph = 0;
#define RUN_PHASE (ph >= lo && ph < hi)
#define END_PHASE do { ++ph; if (ph > lo && ph < hi) GRID_SYNC(); } while (0)

    if (RUN_PHASE) { PHASE_IDS
        if (bid == 0) { if (tid < 64) ctl[tid] = 0u; for (int i = tid; i < XCD_BAR_WORDS; i += 512) ctl[4096 + i] = 0u; }
        LAS float* scr = (LAS float*)(lds + wave * 16384);
        constexpr int I_IN = (D / 64) * (NPROJ / 32), I_SQ = (D / 64) * (D / 32), I_UP = (D / 64) * (FF / 32), I_DN = (FF / 64) * (D / 32);
        constexpr int NITEMS = I_IN + 3 * I_SQ + I_UP + I_DN;
        for (int it = gw; it < NITEMS; it += NGW) {
            int r = it;
            if (r < I_IN) { p0_transpose_item(p.in[I_WIN], D, NPROJ, Win_t, scr, r, lane, true); continue; } r -= I_IN;
            if (r < I_SQ) { p0_transpose_item(p.in[I_WPA], D, D, Wa_t, scr, r, lane, false); continue; } r -= I_SQ;
            if (r < I_SQ) { p0_transpose_item(p.in[I_WPB], D, D, Wb_t, scr, r, lane, false); continue; } r -= I_SQ;
            if (r < I_SQ) { p0_transpose_item(p.in[I_WOUT], D, D, Wout_t, scr, r, lane, false); continue; } r -= I_SQ;
            if (r < I_UP) { p0_transpose_item(p.in[I_WUP], D, FF, Wup_t, scr, r, lane, false); continue; } r -= I_UP;
            p0_transpose_item(p.in[I_WDN], FF, D, Wdn_t, scr, r, lane, false);
        }
        for (int m = gw; m < MR; m += NGW) row_prenorm(p.in[I_XP] + (size_t)m * D, p.in[I_GPRE], HB + (size_t)m * D, lane);
    }
    END_PHASE;

#pragma unroll 1
    for (int rnd = 0; rnd < NROUND; ++rnd) {
        const int T = rnd == 0 ? 4096 : 8192; const int nseq = MR / T;
        const float* xr = rnd == 0 ? p.in[I_XP] : p.in[I_XS] + (size_t)(rnd - 1) * MR * D;
        float* outr = p.out + (size_t)rnd * MR * D;
        if (RUN_PHASE) {
            pg8::Gemm g{HB, Win_t, MR, NPROJ, D}; pg8::StaticOrder S; S.init(MR, NPROJ, G, bid);
            pg8::Epi<1> E{PROJ, NPROJ, nullptr, 0, 0, VT, T};
            pg8::gemm_phase<pg8::Epi<1>, pg8::StaticOrder, true, true>(lds, g, S, E);
        }
        END_PHASE;
        if (RUN_PHASE) {
            const int nit = nseq * 8 * (T / 64);
            for (int it = bid; it < nit; it += G) { const int c = it % (T / 64), sh = it / (T / 64); hgrn_a_item(lds, PROJ, SBUF, DEC, p.in[I_LBF], p.in[I_LBB], sh / 8, sh % 8, c, T); }
        }
        END_PHASE;
        if (RUN_PHASE) {
            const int nit = nseq * 8 * 2 * 8;
            for (int it = bid; it < nit; it += G) hgrn_scan_item(SBUF, DEC, it >> 3, it & 7, T / 64);
        }
        END_PHASE;
        if (RUN_PHASE) { PHASE_IDS
            {
                const int nit = nseq * 8 * (T / 64);
                for (int it = bid; it < nit; it += G) { const int c = it % (T / 64), sh = it / (T / 64); hgrn_c_item(lds, PROJ, SBUF, OPART, p.in[I_LBF], p.in[I_LBB], sh / 8, sh % 8, c, T); }
            }
            float lam;
            { float a = p.in[I_LQ1][lane] * p.in[I_LK1][lane], b = p.in[I_LQ2][lane] * p.in[I_LK2][lane]; a = wave_sum(a); b = wave_sum(b); lam = expf(a) - expf(b) + 0.2f; }
            const int nqb = T / 256, nitems = nseq * 8 * nqb;
            LAS int* slot = (LAS int*)(lds + AT_TAB + 2048);
            if (G == 256) {
                const int xcd = bid & 7, j = bid >> 3;
                for (int i = 0; i < nitems / 256; ++i) {
                    const int li = i * 32 + j, sh = xcd + 8 * (li / nqb), qb = li % nqb;
                    attn_item(lds, PROJ, VT, OA, STASH, p.in[I_RELB], p.in[I_GSUB], lam, sh / 8, sh % 8, qb, T);
                }
            } else {
                for (;;) {
                    __syncthreads();
                    if (tid == 0) *slot = (int)atomicAdd(&ctl[rnd], 1u);
                    __syncthreads();
                    const int it = *slot;
                    if (it >= nitems) break;
                    const int qb = it % nqb, sh = it / nqb;
                    attn_item(lds, PROJ, VT, OA, STASH, p.in[I_RELB], p.in[I_GSUB], lam, sh / 8, sh % 8, qb, T);
                }
            }
        }
        END_PHASE;
        if (RUN_PHASE) { PHASE_IDS
            pg8::Gemm g{OA, Wa_t, MR, D, D}; pg8::StaticOrder S; S.init(MR, D, G, bid);
            pg8::Epi<2> E{MERGED, D, PROJ, NPROJ, C_GA, nullptr, 0};
            pg8::gemm_phase<pg8::Epi<2>, pg8::StaticOrder, true, true>(lds, g, S, E);
            for (int m = gw; m < MR; m += NGW)
                row_hgrn_fin(OPART + (size_t)m * D, OPART + (size_t)MR * D + (size_t)m * D, PROJ + (size_t)m * NPROJ + C_GOG, p.in[I_GHO], OB + (size_t)m * D, lane);
        }
        END_PHASE;
        if (RUN_PHASE) {
            pg8::Gemm g{OB, Wb_t, MR, D, D}; pg8::StaticOrder S; S.init(MR, D, G, bid);
            pg8::Epi<3> E{MERGED, D, PROJ, NPROJ, C_GB, nullptr, 0};
            pg8::gemm_phase<pg8::Epi<3>, pg8::StaticOrder, true, true>(lds, g, S, E);
        }
        END_PHASE;
        if (RUN_PHASE) {
            pg8::Gemm g{MERGED, Wout_t, MR, D, D}; pg8::StaticOrder S; S.init(MR, D, G, bid);
            pg8::Epi<0> E{Y, D, nullptr, 0, 0, nullptr, 0};
            pg8::gemm_phase<pg8::Epi<0>, pg8::StaticOrder, true, true>(lds, g, S, E);
        }
        END_PHASE;
        if (RUN_PHASE) { PHASE_IDS
            for (int m = gw; m < MR; m += NGW)
                row_normres1(xr + (size_t)m * D, Y + (size_t)m * D, p.in[I_GPOST], p.in[I_GMPRE], outr + (size_t)m * D, HB + (size_t)m * D, lane);
        }
        END_PHASE;
        if (RUN_PHASE) {
            pg8::Gemm g{HB, Wup_t, MR, FF, D}; pg8::StaticOrder S; S.init(MR, FF, G, bid);
            pg8::Epi<4> E{U, FF, nullptr, 0, 0, nullptr, 0};
            pg8::gemm_phase<pg8::Epi<4>, pg8::StaticOrder, true, true>(lds, g, S, E);
        }
        END_PHASE;
        if (RUN_PHASE) {
            pg8::Gemm g{U, Wdn_t, MR, D, FF}; pg8::StaticOrder S; S.init(MR, D, G, bid);
            pg8::Epi<0> E{Y, D, nullptr, 0, 0, nullptr, 0};
            pg8::gemm_phase<pg8::Epi<0>, pg8::StaticOrder, true, true>(lds, g, S, E);
        }
        END_PHASE;
        if (RUN_PHASE) { PHASE_IDS
            for (int m = gw; m < MR; m += NGW) row_final(Y + (size_t)m * D, p.in[I_GMPOST], outr + (size_t)m * D, lane);
            if (rnd + 1 < NROUND) {
                const float* xn = p.in[I_XS] + (size_t)rnd * MR * D;
                for (int m = gw; m < MR; m += NGW) row_prenorm(xn + (size_t)m * D, p.in[I_GPRE], HB + (size_t)m * D, lane);
            }
        }
        END_PHASE;
    }
}

constexpr int NPHASES = 1 + NROUND * 11;

extern "C" void kernel_launch(void* const* d_in, const int* in_sizes, int n_in, void* d_out, int out_size, void* d_ws, size_t ws_size, hipStream_t stream) {
    static int grid = 0;
    if (grid == 0) {
        if (n_in != 21 || ws_size < WS_END) { fprintf(stderr, "kernel_launch: unexpected n_in %d / ws %zu\n", n_in, ws_size); grid = -1; return; }
        int dev = 0, cus = 0, per_cu = 0;
        hipGetDevice(&dev);
        hipDeviceGetAttribute(&cus, hipDeviceAttributeMultiprocessorCount, dev);
        hipFuncSetAttribute((const void*)fwd_kernel, hipFuncAttributeMaxDynamicSharedMemorySize, LDS_BYTES);
        hipOccupancyMaxActiveBlocksPerMultiprocessor(&per_cu, (const void*)fwd_kernel, 512, LDS_BYTES);
        if (per_cu < 1) { fprintf(stderr, "kernel_launch: occupancy query says %d blocks/CU\n", per_cu); per_cu = 1; }
        (void)hipGetLastError();
        grid = cus;
    }
    if (grid < 0) return;
    Params p{};
    for (int i = 0; i < 21; ++i) p.in[i] = (const float*)d_in[i];
    p.out = (float*)d_out; p.ws = (unsigned char*)d_ws;
#if N_LAUNCH_MODE == 1
    p.ph_lo = 0; p.ph_hi = NPHASES;
    void* args[] = {&p};
    hipError_t e = hipLaunchCooperativeKernel((const void*)fwd_kernel, dim3(grid), dim3(512), args, LDS_BYTES, stream);
    if (e != hipSuccess) fprintf(stderr, "cooperative launch failed: %s (grid %d)\n", hipGetErrorString(e), grid);
#else
    for (int i = 0; i < NPHASES; ++i) { p.ph_lo = i; p.ph_hi = i + 1; hipLaunchKernelGGL(fwd_kernel, dim3(grid), dim3(512), LDS_BYTES, stream, p); }
#endif
}
```
